# Optimizing an MI355X kernel written in HIP

```python
import math
import jax, jax.numpy as jnp
from jax import lax
import numpy as np

D_MODEL = 1024
BATCH = 32
SEQ = 2048
DEPTH = 4

GRID_W = 64
CTX_LEN = 256
HEAD_DIM = 64
ROPE_THETA = 10000.0
EPS = 1e-6
Q_BLOCK = 128
A_Q_HEADS = 8
A_KV_HEADS = 2
A_WIDTH = A_Q_HEADS * HEAD_DIM
A_KV_WIDTH = A_KV_HEADS * HEAD_DIM
B_WIDTH = D_MODEL // 2
B_WINDOWS = (2, 4, 8, 16)
B_GROUPS = len(B_WINDOWS)
B_GROUP_W = B_WIDTH // B_GROUPS
EVEN_IN = A_WIDTH + 2 * A_KV_WIDTH + B_WIDTH
EVEN_MIX = A_WIDTH + B_WIDTH
C_Q_HEADS = 16
C_KV_HEADS = 4
C_WIDTH = C_Q_HEADS * HEAD_DIM
C_KV_WIDTH = C_KV_HEADS * HEAD_DIM
ODD_IN = C_WIDTH + 2 * C_KV_WIDTH
WINDOW = 128
N_SIDE = WINDOW // Q_BLOCK
BAND_BLOCKS = 2 * N_SIDE + 1
BAND_LEN = BAND_BLOCKS * Q_BLOCK
FFN_HIDDEN = int(math.ceil(8 * D_MODEL / 3 / 256)) * 256
N_EVEN = (DEPTH + 1) // 2
N_ODD = DEPTH // 2

kernel_name = "hybrid_dit_gqa_pool_swa_prefix"


def rmsnorm(x, g):
    xf = x.astype(jnp.float32)
    y = xf * lax.rsqrt(jnp.mean(xf * xf, axis=-1, keepdims=True) + EPS)
    return (y * g.astype(jnp.float32)).astype(x.dtype)


def modulate(x, g, shift, scale):
    return rmsnorm(x, g) * (1 + scale) + shift


def split_heads(t, h):
    return t.reshape(t.shape[0], t.shape[1], h, HEAD_DIM)


def axial_rope(x, rows, cols):
    hd = x.shape[-1]
    quarter = hd // 4
    freqs = ROPE_THETA ** (-jnp.arange(quarter, dtype=jnp.float32) / quarter)

    def rot(a, pos):
        ang = pos.astype(jnp.float32)[:, None] * freqs[None, :]
        cos = jnp.cos(ang)[None, :, None, :]
        sin = jnp.sin(ang)[None, :, None, :]
        a1, a2 = a[..., :quarter], a[..., quarter:]
        return jnp.concatenate([a1 * cos - a2 * sin, a2 * cos + a1 * sin], axis=-1)

    out = jnp.concatenate([rot(x[..., :hd // 2], rows), rot(x[..., hd // 2:], cols)], axis=-1)
    return out.astype(x.dtype)


def dense_gqa_blocks(q, k, v):
    B, S, H, hd = q.shape
    KV = k.shape[2]
    G = H // KV
    nb = S // Q_BLOCK
    scale = 1.0 / math.sqrt(hd)
    qb = q.reshape(B, nb, Q_BLOCK, KV, G, hd).transpose(1, 0, 2, 3, 4, 5)

    def one(qblk):
        s = jnp.einsum('bqkgd,btkd->bkgqt', qblk, k, preferred_element_type=jnp.float32) * scale
        p = jax.nn.softmax(s, axis=-1).astype(v.dtype)
        return jnp.einsum('bkgqt,btkd->bqkgd', p, v)

    o = lax.map(one, qb)
    return o.transpose(1, 0, 2, 3, 4, 5).reshape(B, S, H * hd)


def ctx_attention(q, k, v, sink=None):
    B, T, H, hd = q.shape
    KV = k.shape[2]
    G = H // KV
    scale = 1.0 / math.sqrt(hd)
    qg = q.reshape(B, T, KV, G, hd)
    s = jnp.einsum('bqkgd,btkd->bkgqt', qg, k, preferred_element_type=jnp.float32) * scale
    if sink is not None:
        s_sink = jnp.broadcast_to(sink.reshape(KV, G)[None, :, :, None, None].astype(jnp.float32),
                                  (B, KV, G, T, 1))
        s = jnp.concatenate([s, s_sink], axis=-1)
    p = jax.nn.softmax(s, axis=-1)
    if sink is not None:
        p = p[..., :-1]
    o = jnp.einsum('bkgqt,btkd->bqkgd', p.astype(v.dtype), v)
    return o.reshape(B, T, H * hd)


def window_gqa_blocks(q, k, v, k_ctx, v_ctx, sink):
    B, S, H, hd = q.shape
    KV = k.shape[2]
    G = H // KV
    C = k_ctx.shape[1]
    nb = S // Q_BLOCK
    scale = 1.0 / math.sqrt(hd)
    qb = q.reshape(B, nb, Q_BLOCK, KV, G, hd).transpose(1, 0, 2, 3, 4, 5)

    def band(t):
        tp = jnp.pad(t, ((0, 0), (WINDOW, WINDOW), (0, 0), (0, 0)))
        tp = tp.reshape(B, nb + 2 * N_SIDE, Q_BLOCK, KV, hd)
        tb = jnp.concatenate([tp[:, j:j + nb] for j in range(BAND_BLOCKS)], axis=2)
        return tb.transpose(1, 0, 2, 3, 4)

    kb, vb = band(k), band(v)
    n_i = jnp.arange(nb)[:, None, None]
    q_i = jnp.arange(Q_BLOCK)[None, :, None]
    k_j = jnp.arange(BAND_LEN)[None, None, :]
    qpos = n_i * Q_BLOCK + q_i
    kpos = n_i * Q_BLOCK - WINDOW + k_j
    mask = (kpos >= 0) & (kpos < S) & (jnp.abs(qpos - kpos) <= WINDOW)
    sink_l = sink.reshape(KV, G)[None, :, :, None, None].astype(jnp.float32)

    def one(args):
        qblk, kblk, vblk, m = args
        s_w = jnp.einsum('bqkgd,btkd->bkgqt', qblk, kblk, preferred_element_type=jnp.float32) * scale
        s_w = jnp.where(m[None, None, None], s_w, -jnp.inf)
        s_c = jnp.einsum('bqkgd,btkd->bkgqt', qblk, k_ctx, preferred_element_type=jnp.float32) * scale
        s_s = jnp.broadcast_to(sink_l, (B, KV, G, Q_BLOCK, 1))
        p = jax.nn.softmax(jnp.concatenate([s_w, s_c, s_s], axis=-1), axis=-1).astype(v.dtype)
        o = jnp.einsum('bkgqt,btkd->bqkgd', p[..., :BAND_LEN], vblk)
        o = o + jnp.einsum('bkgqt,btkd->bqkgd', p[..., BAND_LEN:BAND_LEN + C], v_ctx)
        return o

    o = lax.map(one, (qb, kb, vb, mask))
    return o.transpose(1, 0, 2, 3, 4, 5).reshape(B, S, H * hd)


def centred_mean(u, w):
    S = u.shape[1]
    cs = jnp.pad(jnp.cumsum(u.astype(jnp.float32), axis=1), ((0, 0), (1, 0), (0, 0)))
    t = jnp.arange(S)
    lo = jnp.clip(t - w // 2, 0, S)
    hi = jnp.clip(t + w - w // 2, 0, S)
    cnt = (hi - lo).astype(jnp.float32)
    return ((cs[:, hi] - cs[:, lo]) / cnt[None, :, None]).astype(u.dtype)


def pool_mixer(u, w_pool, pool_scale):
    B, S, _ = u.shape
    diffs = []
    for g, w in enumerate(B_WINDOWS):
        ug = u[..., g * B_GROUP_W:(g + 1) * B_GROUP_W]
        diffs.append(centred_mean(ug, w) - ug)
    d = jnp.stack(diffs, axis=2)
    y = jnp.einsum('bsgc,gcd->bsgd', d, w_pool).reshape(B, S, B_WIDTH)
    return y * pool_scale


def even_mixer(h, hc, w_in, w_out, q_gain, k_gain, w_pool, pool_scale, rows, cols, with_ctx):
    def project(t):
        p = t @ w_in
        q, k, v, u = jnp.split(p, [A_WIDTH, A_WIDTH + A_KV_WIDTH, A_WIDTH + 2 * A_KV_WIDTH], axis=-1)
        q = rmsnorm(split_heads(q, A_Q_HEADS), q_gain)
        k = rmsnorm(split_heads(k, A_KV_HEADS), k_gain)
        return q, k, split_heads(v, A_KV_HEADS), u

    q, k, v, u = project(h)
    qc, kc, vc, uc = project(hc)
    q = axial_rope(q, rows, cols)
    k = axial_rope(k, rows, cols)
    a = dense_gqa_blocks(q, jnp.concatenate([k, kc], axis=1), jnp.concatenate([v, vc], axis=1))
    b = pool_mixer(u, w_pool, pool_scale)
    y = jnp.concatenate([a, b], axis=-1) @ w_out
    yc = None
    if with_ctx:
        ac = ctx_attention(qc, kc, vc)
        bc = pool_mixer(uc, w_pool, pool_scale)
        yc = jnp.concatenate([ac, bc], axis=-1) @ w_out
    return y, yc


def odd_mixer(h, hc, w_in, w_out, sink, rows, cols, with_ctx):
    def project(t):
        p = t @ w_in
        q, k, v = jnp.split(p, [C_WIDTH, C_WIDTH + C_KV_WIDTH], axis=-1)
        return split_heads(q, C_Q_HEADS), split_heads(k, C_KV_HEADS), split_heads(v, C_KV_HEADS)

    q, k, v = project(h)
    qc, kc, vc = project(hc)
    q = axial_rope(q, rows, cols)
    k = axial_rope(k, rows, cols)
    y = window_gqa_blocks(q, k, v, kc, vc, sink) @ w_out
    yc = None
    if with_ctx:
        yc = ctx_attention(qc, kc, vc, sink) @ w_out
    return y, yc


def swiglu(h, w_in, w_out):
    g, u = jnp.split(h @ w_in, 2, axis=-1)
    return (jax.nn.silu(g) * u) @ w_out


def setup_inputs(seed: int = 0) -> dict:
    key = jax.random.key(seed)
    ks = jax.random.split(key, 24)
    D = D_MODEL

    def nrm(k, shape, std):
        return jax.random.normal(k, shape, dtype=jnp.float32) * std

    return {
        "x": nrm(ks[0], (BATCH, SEQ, D), 1.0),
        "c": nrm(ks[1], (BATCH, D), 1.0),
        "ctx": nrm(ks[2], (BATCH, CTX_LEN, D), 1.0),
        "c_ctx": nrm(ks[3], (D,), 1.0),
        "w_mod": nrm(ks[4], (DEPTH, D, 6 * D), 0.5 * D ** -0.5),
        "b_mod": nrm(ks[5], (DEPTH, 6 * D), 0.02),
        "g_pre_mix": 1.0 + nrm(ks[6], (DEPTH, D), 0.05),
        "g_post_mix": 1.0 + nrm(ks[7], (DEPTH, D), 0.05),
        "g_pre_ffn": 1.0 + nrm(ks[8], (DEPTH, D), 0.05),
        "g_post_ffn": 1.0 + nrm(ks[9], (DEPTH, D), 0.05),
        "we_in": nrm(ks[10], (N_EVEN, D, EVEN_IN), D ** -0.5),
        "we_out": nrm(ks[11], (N_EVEN, EVEN_MIX, D), EVEN_MIX ** -0.5),
        "we_q_gain": 1.0 + nrm(ks[12], (N_EVEN, HEAD_DIM), 0.05),
        "we_k_gain": 1.0 + nrm(ks[13], (N_EVEN, HEAD_DIM), 0.05),
        "we_pool": nrm(ks[14], (N_EVEN, B_GROUPS, B_GROUP_W, B_GROUP_W), B_GROUP_W ** -0.5),
        "we_pool_scale": 1.0 + nrm(ks[15], (N_EVEN, B_WIDTH), 0.1),
        "wo_in": nrm(ks[16], (N_ODD, D, ODD_IN), D ** -0.5),
        "wo_out": nrm(ks[17], (N_ODD, C_WIDTH, D), C_WIDTH ** -0.5),
        "wo_sink": nrm(ks[18], (N_ODD, C_Q_HEADS), 0.5),
        "w_ffn_in": nrm(ks[19], (DEPTH, D, 2 * FFN_HIDDEN), D ** -0.5),
        "w_ffn_out": nrm(ks[20], (DEPTH, FFN_HIDDEN, D), FFN_HIDDEN ** -0.5),
    }


def reference(x, c, ctx, c_ctx, w_mod, b_mod, g_pre_mix, g_post_mix, g_pre_ffn, g_post_ffn,
              we_in, we_out, we_q_gain, we_k_gain, we_pool, we_pool_scale,
              wo_in, wo_out, wo_sink, w_ffn_in, w_ffn_out):
    S = x.shape[1]
    ROWS = S // GRID_W
    rows = jnp.repeat(jnp.arange(ROWS, dtype=jnp.int32), GRID_W)
    cols = jnp.tile(jnp.arange(GRID_W, dtype=jnp.int32), ROWS)
    silu_c = jax.nn.silu(c)
    silu_cc = jax.nn.silu(c_ctx)

    for l in range(DEPTH):
        with_ctx = l < DEPTH - 1
        mod = (silu_c @ w_mod[l] + b_mod[l])[:, None, :]
        mod_c = (silu_cc @ w_mod[l] + b_mod[l])[None, None, :]
        sh_m, sc_m, gt_m, sh_f, sc_f, gt_f = jnp.split(mod, 6, axis=-1)
        csh_m, csc_m, cgt_m, csh_f, csc_f, cgt_f = jnp.split(mod_c, 6, axis=-1)

        h = modulate(x, g_pre_mix[l], sh_m, sc_m)
        hc = modulate(ctx, g_pre_mix[l], csh_m, csc_m)
        i = l // 2
        if l % 2 == 0:
            y, yc = even_mixer(h, hc, we_in[i], we_out[i], we_q_gain[i], we_k_gain[i],
                               we_pool[i], we_pool_scale[i], rows, cols, with_ctx)
        else:
            y, yc = odd_mixer(h, hc, wo_in[i], wo_out[i], wo_sink[i], rows, cols, with_ctx)

        x = x + gt_m * rmsnorm(y, g_post_mix[l])
        h = modulate(x, g_pre_ffn[l], sh_f, sc_f)
        x = x + gt_f * rmsnorm(swiglu(h, w_ffn_in[l], w_ffn_out[l]), g_post_ffn[l])

        if with_ctx:
            ctx = ctx + cgt_m * rmsnorm(yc, g_post_mix[l])
            hc = modulate(ctx, g_pre_ffn[l], csh_f, csc_f)
            ctx = ctx + cgt_f * rmsnorm(swiglu(hc, w_ffn_in[l], w_ffn_out[l]), g_post_ffn[l])
    return x
```

```cpp
#include <hip/hip_runtime.h>
#include <hip/hip_cooperative_groups.h>
#include <cstdio>
#include <cstdint>
namespace cg = cooperative_groups;

#define DI __device__ __forceinline__
#define LAS __attribute__((address_space(3)))
typedef unsigned short bf16_t;
typedef short bf16x8 __attribute__((ext_vector_type(8)));
typedef short s16x4 __attribute__((ext_vector_type(4)));
typedef float f32x4 __attribute__((ext_vector_type(4)));
typedef float f32x16 __attribute__((ext_vector_type(16)));
typedef unsigned u32x4 __attribute__((ext_vector_type(4)));
typedef unsigned u32x2 __attribute__((ext_vector_type(2)));
typedef float f32x2_t __attribute__((ext_vector_type(2)));
typedef __bf16 bf16x2_t __attribute__((ext_vector_type(2)));

DI unsigned cvtpk(float lo, float hi) { f32x2_t v = {lo, hi}; bf16x2_t b = __builtin_convertvector(v, bf16x2_t); return __builtin_bit_cast(unsigned, b); }
DI float bf2f(unsigned short b) { return __uint_as_float(((unsigned)b) << 16); }
DI float bflo(unsigned w) { return __uint_as_float(w << 16); }
DI float bfhi(unsigned w) { return __uint_as_float(w & 0xffff0000u); }

constexpr int DM = 1024, NBATCH = 32, SEQ = 2048, CTX = 256, NLAYER = 4;
constexpr int NL = NBATCH * SEQ;
constexpr int NC = NBATCH * CTX;
constexpr int NT = NL + NC;
constexpr int GROWS = 36864, GLAT = 32768, GPAN = 144;
constexpr int KVR = SEQ + CTX;
constexpr int FFN = 2816;
constexpr float EPS = 1e-6f;
constexpr float LOG2E = 1.4426950408889634f;
constexpr float C2 = 0.125f * LOG2E;

constexpr size_t MiB = 1u << 20;
constexpr size_t WS_MOD = 1 * MiB;
constexpr size_t WS_ROPE = 5 * MiB;
constexpr size_t WS_PART = 6 * MiB;
constexpr size_t WS_PART2 = 11 * MiB;
constexpr size_t WS_W = 16 * MiB;
constexpr size_t WL_IN = 0, WL_OUT = 3 * MiB, WL_POOL = 5 * MiB, WL_F1 = 6 * MiB, WL_F2 = 17 * MiB, WL_STRIDE = 24 * MiB;
constexpr size_t WS_XC = 112 * MiB;
constexpr size_t WS_H = 144 * MiB;
constexpr size_t WS_Y = 288 * MiB;
constexpr size_t WS_Q = 432 * MiB;
constexpr size_t WS_K = 576 * MiB;
constexpr size_t WS_VT = 612 * MiB;
constexpr size_t WS_U = 648 * MiB;
constexpr size_t WS_MIX = 720 * MiB;
constexpr size_t WS_ACT = 432 * MiB;
constexpr size_t WS_Y2 = 864 * MiB;
constexpr size_t WS_END = 1008 * MiB;
constexpr int LDS_BYTES = 147456;

namespace pg8 {
#define PG8_LAS __attribute__((address_space(3)))
constexpr int BM = 256, BK = 64, HALF = 128, HTB = HALF * BK * 2, STAGE_BYTES = 8 * HTB, NXCD = 8, WGM = 4;
__host__ __device__ __forceinline__ int lds_byte(int r, int c) { const int st = (r >> 4) * 2 + (c >> 5), rr = r & 15, cc = c & 31, ob = rr * 64 + cc * 2; return st * 1024 + (ob ^ (((ob >> 9) & 1) << 5)); }
__host__ __device__ __forceinline__ void stage_rc(int b, int& R, int& C) { const int st = b / 1024, sb = b % 1024, swz = sb ^ (((sb >> 9) & 1) << 5); R = (st >> 1) * 16 + swz / 64; C = (st & 1) * 32 + (swz % 64) / 2; }
struct Unit { int pm, pn; };
struct Gemm { const bf16_t* A; const bf16_t* Bt; int M, N, K; };
struct StaticOrder {
    int nM, nN, nwg, G, c;
    __host__ __device__ void init(int M, int N, int G_, int c_) { nM = M / BM; nN = N / BM; nwg = nM * nN; G = G_; c = c_; }
    __host__ __device__ bool next(int i, Unit& u) const {
        const long L = (long)i * G + c; if (L >= nwg) return false;
        int wgid = (int)L; { const int q = nwg / NXCD, r = nwg % NXCD, xcd = wgid % NXCD, off = wgid / NXCD; wgid = (xcd < r ? xcd * (q + 1) : r * (q + 1) + (xcd - r) * q) + off; }
        const int nig = WGM * nN, gid = wgid / nig, fm = gid * WGM, gsz = (nM - fm) < WGM ? (nM - fm) : WGM;
        u.pm = fm + ((wgid % nig) % gsz); u.pn = (wgid % nig) / gsz; return true;
    }
};
struct GroupOrder {
    StaticOrder base; int g;
    __host__ __device__ void init(int Mlog, int N, int Gg, int c, int g_) { base.init(Mlog, N, Gg, c); g = g_; }
    __host__ __device__ bool next(int i, Unit& u) const {
        if (!base.next(i, u)) return false;
        u.pm += 144 * g; return true;
    }
};
template <class Epi, class Sched>
__device__ __forceinline__ void gemm_phase(PG8_LAS unsigned char* lds, const Gemm g, const Sched& S, const Epi& E) {
    int tid_ = threadIdx.x; asm volatile("" : "+v"(tid_));
    const int tid = tid_, wid = __builtin_amdgcn_readfirstlane(tid >> 6), lane = tid & 63, wr = wid >> 2, wc = wid & 3, fr = lane & 15, fq = lane >> 4;
    const int K = g.K, nt = K / BK;
    unsigned voffA[2], voffB[2];
#pragma unroll
    for (int i = 0; i < 2; ++i) { int R, C; stage_rc(tid * 16 + i * 8192, R, C); voffA[i] = (unsigned)(R * K + C) * 2u; voffB[i] = voffA[i]; }
    const size_t kstep = (size_t)(BK * 2);
    const size_t hstep = (size_t)HALF * K * 2;
    const size_t tstep = 2 * hstep;
    const unsigned ldsw = (unsigned)wid * 1024u;
    const int aoff = lds_byte(wr * 64 + fr, fq * 8), boff = lds_byte(wc * 32 + fr, fq * 8);
#define PG8_SA(b, h) (((b) * 2 + (h)) * HTB)
#define PG8_SB(b, h) ((4 + (b) * 2 + (h)) * HTB)
#define PG8_STAGE(bufoff, gbase, voff) do { _Pragma("unroll") for (int _i = 0; _i < 2; ++_i) \
        __builtin_amdgcn_global_load_lds((const unsigned*)((const char*)(gbase) + (voff)[_i]), (PG8_LAS unsigned*)(lds + (bufoff) + ldsw + _i * 8192), 16, 0, 0); } while (0)
#define PG8_LDA(dst, b, h) do { _Pragma("unroll") for (int m = 0; m < 4; ++m) _Pragma("unroll") for (int k = 0; k < 2; ++k) dst[m][k] = *(const PG8_LAS bf16x8*)(lds + PG8_SA(b, h) + aoff + m * 2048 + k * 1024); } while (0)
#define PG8_LDB(dst, b, h) do { _Pragma("unroll") for (int n = 0; n < 2; ++n) _Pragma("unroll") for (int k = 0; k < 2; ++k) dst[n][k] = *(const PG8_LAS bf16x8*)(lds + PG8_SB(b, h) + boff + n * 2048 + k * 1024); } while (0)
#define PG8_MMA(ai, bj, At, Bt) do { __builtin_amdgcn_s_setprio(1); _Pragma("unroll") for (int m = 0; m < 4; ++m) _Pragma("unroll") for (int n = 0; n < 2; ++n) _Pragma("unroll") for (int k = 0; k < 2; ++k) \
        acc[ai][bj][m][n] = __builtin_amdgcn_mfma_f32_16x16x32_bf16(Bt[n][k], At[m][k], acc[ai][bj][m][n], 0, 0, 0); __builtin_amdgcn_s_setprio(0); } while (0)
#define PG8_WAIT_V(n) asm volatile("s_waitcnt vmcnt(" #n ")" ::: "memory")
#define PG8_WAIT_L(n) asm volatile("s_waitcnt lgkmcnt(" #n ")" ::: "memory")
#define PG8_BAR __builtin_amdgcn_s_barrier()
#define PG8_SCHED __builtin_amdgcn_sched_barrier(0)
    Unit cur, nxt; int ui = 0;
    if (!S.next(0, cur)) return;
    f32x4 acc[2][2][4][2];
#pragma unroll
    for (int a = 0; a < 2; ++a)
#pragma unroll
        for (int b = 0; b < 2; ++b)
#pragma unroll
            for (int m = 0; m < 4; ++m)
#pragma unroll
                for (int n = 0; n < 2; ++n) acc[a][b][m][n] = (f32x4){0.f, 0.f, 0.f, 0.f};
    bf16x8 At[4][2], B0[2][2], B1[2][2];
    const char* cA = (const char*)g.A + (size_t)cur.pm * tstep; const char* cB = (const char*)g.Bt + (size_t)cur.pn * tstep;
    PG8_STAGE(PG8_SB(0, 0), cB, voffB); PG8_STAGE(PG8_SB(0, 1), cB + hstep, voffB); PG8_STAGE(PG8_SA(0, 0), cA, voffA); PG8_STAGE(PG8_SA(0, 1), cA + hstep, voffA);
    if (wr == 1) PG8_BAR;
    PG8_WAIT_V(2); PG8_BAR;
    PG8_STAGE(PG8_SB(1, 0), cB + kstep, voffB); PG8_STAGE(PG8_SA(1, 0), cA + kstep, voffA); PG8_STAGE(PG8_SB(1, 1), cB + hstep + kstep, voffB);
    PG8_WAIT_V(6); PG8_BAR;
    for (;;) {
        const bool has_next = S.next(ui + 1, nxt);
        const char* nA = has_next ? (const char*)g.A + (size_t)nxt.pm * tstep : cA; const char* nB = has_next ? (const char*)g.Bt + (size_t)nxt.pn * tstep : cB;
        for (int t = 0; t < nt; t += 2) {
            const bool last = (t == nt - 2);
            const char* a1 = cA + (size_t)(t + 1) * kstep;
            const char* a2 = last ? nA : cA + (size_t)(t + 2) * kstep; const char* b2 = last ? nB : cB + (size_t)(t + 2) * kstep;
            const char* a3 = a2 + kstep; const char* b3 = b2 + kstep;
            PG8_LDB(B0, 0, 0); PG8_LDB(B1, 0, 1); PG8_SCHED; PG8_LDA(At, 0, 0); PG8_STAGE(PG8_SA(1, 1), a1 + hstep, voffA);
            PG8_WAIT_V(8); PG8_WAIT_L(0); PG8_BAR; PG8_MMA(0, 0, At, B0); PG8_MMA(0, 1, At, B1); PG8_BAR; PG8_SCHED;
            PG8_LDA(At, 0, 1); PG8_STAGE(PG8_SB(0, 0), b2, voffB); PG8_STAGE(PG8_SB(0, 1), b2 + hstep, voffB); PG8_STAGE(PG8_SA(0, 0), a2, voffA);
            PG8_WAIT_V(8); PG8_WAIT_L(0); PG8_BAR; PG8_MMA(1, 0, At, B0); PG8_MMA(1, 1, At, B1); PG8_BAR; PG8_SCHED;
            PG8_LDB(B0, 1, 0); PG8_LDB(B1, 1, 1); PG8_SCHED; PG8_LDA(At, 1, 0); PG8_STAGE(PG8_SA(0, 1), a2 + hstep, voffA);
            PG8_WAIT_V(8); PG8_WAIT_L(0); PG8_BAR; PG8_MMA(0, 0, At, B0); PG8_MMA(0, 1, At, B1); PG8_BAR; PG8_SCHED;
            PG8_LDA(At, 1, 1); PG8_STAGE(PG8_SB(1, 0), b3, voffB); PG8_STAGE(PG8_SB(1, 1), b3 + hstep, voffB); PG8_STAGE(PG8_SA(1, 0), a3, voffA);
            PG8_WAIT_V(8); PG8_WAIT_L(0); PG8_BAR; PG8_MMA(1, 0, At, B0); PG8_MMA(1, 1, At, B1); PG8_BAR; PG8_SCHED;
        }
        if (wr == 0) PG8_BAR;
        E(acc, cur, wr, wc, fr, fq);
        if (!has_next) break;
#pragma unroll
        for (int a = 0; a < 2; ++a)
#pragma unroll
            for (int b = 0; b < 2; ++b)
#pragma unroll
                for (int m = 0; m < 4; ++m)
#pragma unroll
                    for (int n = 0; n < 2; ++n) acc[a][b][m][n] = (f32x4){0.f, 0.f, 0.f, 0.f};
        cur = nxt; cA = nA; cB = nB; ++ui;
        if (wr == 1) PG8_BAR;
    }
    PG8_WAIT_V(0);
    PG8_BAR;
#undef PG8_SA
#undef PG8_SB
#undef PG8_STAGE
#undef PG8_LDA
#undef PG8_LDB
#undef PG8_MMA
#undef PG8_WAIT_V
#undef PG8_WAIT_L
#undef PG8_BAR
#undef PG8_SCHED
}
}

struct EpiQKV {
    int even;
    bf16_t* Q; bf16_t* Kb; bf16_t* Vt; bf16_t* U;
    const float* qg; const float* kg; const LAS float* rope; unsigned* maxw;
    DI void operator()(const f32x4 (&acc)[2][2][4][2], const pg8::Unit& u, int wr, int wc, int fr, int fq) const {
        int kind, head;
        const int pn = u.pn;
        if (even) { if (pn < 2) { kind = 0; head = pn * 4 + wc; } else if (pn == 2) { if (wc < 2) { kind = 1; head = wc; } else { kind = 2; head = wc - 2; } } else { kind = 3; head = (pn - 3) * 4 + wc; } }
        else { if (pn < 4) { kind = 0; head = pn * 4 + wc; } else if (pn == 4) { kind = 1; head = wc; } else { kind = 2; head = wc; } }
        const int qw = even ? 512 : 1024, kvw = even ? 128 : 256, nkv = even ? 2 : 4;
        const int gq = u.pm / GPAN, pl = u.pm - gq * GPAN;
        const bool lat = pl < 128;
        int b, pos0;
        if (lat) { b = 16 * gq + (pl >> 3); pos0 = (pl & 7) * 256; } else { b = 16 * gq + (pl - 128); pos0 = SEQ; }
        const int half = fq >> 1, f0 = 8 * (fq & 1);
        const int dbase = 32 * half + f0;
        f32x4 gn[2][2];
        const bool donorm = even && kind <= 1;
        if (donorm) { const float* gp = (kind == 0) ? qg : kg;
#pragma unroll
            for (int bj = 0; bj < 2; ++bj)
#pragma unroll
                for (int n = 0; n < 2; ++n) gn[bj][n] = *(const f32x4*)(gp + dbase + 16 * bj + 4 * n); }
        const float qs = (kind == 0) ? C2 : 1.0f;
        float rmaxn = 0.f;
#pragma unroll
        for (int ai = 0; ai < 2; ++ai)
#pragma unroll
            for (int m = 0; m < 4; ++m) {
                const int rl = 128 * ai + 64 * wr + 16 * m + fr;
                const size_t grow = (size_t)u.pm * 256 + rl;
                const int pos = pos0 + rl;
                f32x4 v[2][2];
#pragma unroll
                for (int bj = 0; bj < 2; ++bj)
#pragma unroll
                    for (int n = 0; n < 2; ++n) v[bj][n] = acc[ai][bj][m][n];
                if (kind <= 1) {
                    if (donorm) {
                        float ss = 0.f;
#pragma unroll
                        for (int bj = 0; bj < 2; ++bj)
#pragma unroll
                            for (int n = 0; n < 2; ++n) ss += (v[bj][n][0] * v[bj][n][0] + v[bj][n][1] * v[bj][n][1]) + (v[bj][n][2] * v[bj][n][2] + v[bj][n][3] * v[bj][n][3]);
                        ss += __shfl_xor(ss, 16); ss += __shfl_xor(ss, 32);
                        const float rstd = rsqrtf(ss * (1.0f / 64.0f) + EPS);
#pragma unroll
                        for (int bj = 0; bj < 2; ++bj)
#pragma unroll
                            for (int n = 0; n < 2; ++n) v[bj][n] = v[bj][n] * rstd * gn[bj][n];
                    }
                    if (lat) {
                        const int p = half ? (pos & 63) : (pos >> 6);
                        const LAS f32x4* rp = (const LAS f32x4*)(rope + (p * 16 + f0) * 2);
#pragma unroll
                        for (int n = 0; n < 2; ++n) {
                            const f32x4 cs0 = rp[2 * n], cs1 = rp[2 * n + 1];
                            const float c[4] = {cs0[0], cs0[2], cs1[0], cs1[2]}, s[4] = {cs0[1], cs0[3], cs1[1], cs1[3]};
#pragma unroll
                            for (int i = 0; i < 4; ++i) { const float a1 = v[0][n][i], a2 = v[1][n][i]; v[0][n][i] = a1 * c[i] - a2 * s[i]; v[1][n][i] = a2 * c[i] + a1 * s[i]; }
                        }
                    }
                    if (maxw) { float nn = 0.f;
#pragma unroll
                        for (int bj = 0; bj < 2; ++bj)
#pragma unroll
                            for (int n = 0; n < 2; ++n) nn += (v[bj][n][0] * v[bj][n][0] + v[bj][n][1] * v[bj][n][1]) + (v[bj][n][2] * v[bj][n][2] + v[bj][n][3] * v[bj][n][3]);
                        nn += __shfl_xor(nn, 16); nn += __shfl_xor(nn, 32); rmaxn = fmaxf(rmaxn, nn * qs * qs); }
                    bf16_t* dst = (kind == 0) ? (Q + grow * qw + head * 64) : (Kb + ((size_t)b * KVR + pos) * kvw + head * 64);
#pragma unroll
                    for (int bj = 0; bj < 2; ++bj) {
                        u32x4 w; w.x = cvtpk(v[bj][0][0] * qs, v[bj][0][1] * qs); w.y = cvtpk(v[bj][0][2] * qs, v[bj][0][3] * qs);
                        w.z = cvtpk(v[bj][1][0] * qs, v[bj][1][1] * qs); w.w = cvtpk(v[bj][1][2] * qs, v[bj][1][3] * qs);
                        *(u32x4*)(dst + dbase + 16 * bj) = w;
                    }
                } else if (kind == 2) {
                    const int posp = (pos & ~15) | (pos & 3) | ((pos & 4) << 1) | ((pos & 8) >> 1);
                    bf16_t* dst = Vt + ((size_t)(b * nkv + head) * 64) * KVR + posp;
#pragma unroll
                    for (int bj = 0; bj < 2; ++bj)
#pragma unroll
                        for (int n = 0; n < 2; ++n)
#pragma unroll
                            for (int i = 0; i < 4; ++i) { const int d = dbase + 16 * bj + 4 * n + i; dst[(size_t)d * KVR] = (bf16_t)(cvtpk(v[bj][n][i], 0.f) & 0xffffu); }
                } else {
                    bf16_t* dst = U + grow * 512 + head * 64;
#pragma unroll
                    for (int bj = 0; bj < 2; ++bj) {
                        u32x4 w; w.x = cvtpk(v[bj][0][0], v[bj][0][1]); w.y = cvtpk(v[bj][0][2], v[bj][0][3]);
                        w.z = cvtpk(v[bj][1][0], v[bj][1][1]); w.w = cvtpk(v[bj][1][2], v[bj][1][3]);
                        *(u32x4*)(dst + dbase + 16 * bj) = w;
                    }
                }
            }
        if (maxw && kind <= 1) {
            rmaxn = fmaxf(rmaxn, __shfl_xor(rmaxn, 1)); rmaxn = fmaxf(rmaxn, __shfl_xor(rmaxn, 2)); rmaxn = fmaxf(rmaxn, __shfl_xor(rmaxn, 4)); rmaxn = fmaxf(rmaxn, __shfl_xor(rmaxn, 8));
            if (fr == 0 && fq == 0) __hip_atomic_fetch_max(maxw + b * 20 + (kind == 0 ? head : 16 + head), __float_as_uint(rmaxn), __ATOMIC_RELAXED, __HIP_MEMORY_SCOPE_AGENT);
        }
    }
};

struct EpiY {
    bf16_t* Y; float* PART;
    DI void operator()(const f32x4 (&acc)[2][2][4][2], const pg8::Unit& u, int wr, int wc, int fr, int fq) const {
#pragma unroll
        for (int ai = 0; ai < 2; ++ai)
#pragma unroll
            for (int m = 0; m < 4; ++m) {
                const size_t row = (size_t)u.pm * 256 + 128 * ai + 64 * wr + 16 * m + fr;
                float ss = 0.f;
#pragma unroll
                for (int bj = 0; bj < 2; ++bj) {
                    const f32x4 v0 = acc[ai][bj][m][0], v1 = acc[ai][bj][m][1];
                    ss += (v0[0] * v0[0] + v0[1] * v0[1]) + (v0[2] * v0[2] + v0[3] * v0[3]) + (v1[0] * v1[0] + v1[1] * v1[1]) + (v1[2] * v1[2] + v1[3] * v1[3]);
                    u32x4 w; w.x = cvtpk(v0[0], v0[1]); w.y = cvtpk(v0[2], v0[3]); w.z = cvtpk(v1[0], v1[1]); w.w = cvtpk(v1[2], v1[3]);
                    *(u32x4*)(Y + row * 1024 + u.pn * 256 + 128 * bj + 32 * wc + 8 * fq) = w;
                }
                ss += __shfl_xor(ss, 16); ss += __shfl_xor(ss, 32);
                if (fq == 0) PART[row * 16 + u.pn * 4 + wc] = ss;
            }
    }
};

struct EpiSwiGLU {
    bf16_t* ACT;
    DI void operator()(const f32x4 (&acc)[2][2][4][2], const pg8::Unit& u, int wr, int wc, int fr, int fq) const {
#pragma unroll
        for (int ai = 0; ai < 2; ++ai)
#pragma unroll
            for (int m = 0; m < 4; ++m) {
                const size_t row = (size_t)u.pm * 256 + 128 * ai + 64 * wr + 16 * m + fr;
                float o[2][4];
#pragma unroll
                for (int n = 0; n < 2; ++n)
#pragma unroll
                    for (int i = 0; i < 4; ++i) { const float gt = acc[ai][0][m][n][i], up = acc[ai][1][m][n][i]; o[n][i] = gt * up * __builtin_amdgcn_rcpf(1.0f + __builtin_amdgcn_exp2f(-LOG2E * gt)); }
                u32x4 w; w.x = cvtpk(o[0][0], o[0][1]); w.y = cvtpk(o[0][2], o[0][3]); w.z = cvtpk(o[1][0], o[1][1]); w.w = cvtpk(o[1][2], o[1][3]);
                *(u32x4*)(ACT + row * FFN + u.pn * 128 + 32 * wc + 8 * fq) = w;
            }
    }
};

DI int newrow(int type, int o) {
    if (type == 0) { const int ol = o & 255, bj = ol >> 7, wc = (ol >> 5) & 3, fq = (ol >> 3) & 3, n = (ol >> 2) & 1, i = ol & 3; return (o & ~255) + 128 * bj + 32 * wc + 16 * n + 4 * fq + i; }
    if (type == 1) { const int ol = o & 255, wc = ol >> 6, d = ol & 63, fq = 2 * (d >> 5) + ((d >> 3) & 1), bj = (d >> 4) & 1, n = (d >> 2) & 1, i = d & 3; return (o & ~255) + 128 * bj + 32 * wc + 16 * n + 4 * fq + i; }
    if (type == 2) { const int isu = o >= FFN ? 1 : 0, j = o - FFN * isu, pn = j >> 7, jj = j & 127, wc = jj >> 5, fq = (jj >> 3) & 3, n = (jj >> 2) & 1, i = jj & 3; return pn * 256 + 128 * isu + 32 * wc + 16 * n + 4 * fq + i; }
    return o;
}
DI void prep_item(const float* W, int K, int N, bf16_t* WT, int type, int item, LAS float* scr) {
    int tid_ = threadIdx.x; asm volatile("" : "+v"(tid_)); const int tid = tid_;
    const int nblk = N / 64, kb = item / nblk, nb = item % nblk, k0 = 64 * kb, n0 = 64 * nb;
    { const int r = tid >> 4, c4 = (tid & 15) * 4;
#pragma unroll
      for (int p = 0; p < 2; ++p) { const int kk = r + 32 * p; const f32x4 v = *(const f32x4*)(W + (size_t)(k0 + kk) * N + n0 + c4);
          scr[kk * 65 + c4 + 0] = v[0]; scr[kk * 65 + c4 + 1] = v[1]; scr[kk * 65 + c4 + 2] = v[2]; scr[kk * 65 + c4 + 3] = v[3]; } }
    __syncthreads();
    { const int n = tid >> 3, kc = (tid & 7) * 8; const LAS float* s = scr + kc * 65 + n;
      u32x4 o; o.x = cvtpk(s[0 * 65], s[1 * 65]); o.y = cvtpk(s[2 * 65], s[3 * 65]); o.z = cvtpk(s[4 * 65], s[5 * 65]); o.w = cvtpk(s[6 * 65], s[7 * 65]);
      *(u32x4*)(WT + (size_t)newrow(type, n0 + n) * K + k0 + kc) = o; }
    __syncthreads();
}

DI void prep_layer(int l, int worker, int nworkers, unsigned char* ws, LAS unsigned char* lds, const float* we_in, const float* we_out, const float* we_pool,
                   const float* wo_in, const float* wo_out, const float* w_f1, const float* w_f2) {
    constexpr int I_IN = 384, I_OUT = 256, I_POOL = 16, I_F1 = 1408, I_F2 = 704, I_LAYER = I_IN + I_OUT + I_POOL + I_F1 + I_F2;
    const int li = l >> 1; const bool ev = (l & 1) == 0;
    unsigned char* wl = ws + WS_W + (size_t)l * WL_STRIDE;
    LAS float* scr = (LAS float*)lds;
    for (int it = worker; it < I_LAYER; it += nworkers) {
        int r = it;
        if (r < I_IN) { if (ev) { if (r < 320) prep_item(we_in + (size_t)li * 1024 * 1280, 1024, 1280, (bf16_t*)(wl + WL_IN), 1, r, scr); }
                        else prep_item(wo_in + (size_t)li * 1024 * 1536, 1024, 1536, (bf16_t*)(wl + WL_IN), 1, r, scr); continue; } r -= I_IN;
        if (r < I_OUT) { prep_item((ev ? we_out : wo_out) + (size_t)li * 1024 * 1024, 1024, 1024, (bf16_t*)(wl + WL_OUT), 0, r, scr); continue; } r -= I_OUT;
        if (r < I_POOL) { if (ev) { const int gq = r >> 2; prep_item(we_pool + ((size_t)li * 4 + gq) * 128 * 128, 128, 128, (bf16_t*)(wl + WL_POOL) + (size_t)gq * 128 * 128, 3, r & 3, scr); } continue; } r -= I_POOL;
        if (r < I_F1) { prep_item(w_f1 + (size_t)l * 1024 * 5632, 1024, 5632, (bf16_t*)(wl + WL_F1), 2, r, scr); continue; } r -= I_F1;
        prep_item(w_f2 + (size_t)l * FFN * 1024, FFN, 1024, (bf16_t*)(wl + WL_F2), 0, r, scr);
    }
}

DI void mod_item(int item, const float* c, const float* cctx, const float* w_mod, const float* b_mod, float* MOD, LAS unsigned char* lds) {
    const int tid = threadIdx.x;
    const int l = item / 48, n0 = (item % 48) * 128;
    LAS float* S = (LAS float*)lds;
    for (int idx = tid; idx < 33 * 1024; idx += 512) { const int b = idx >> 10, k = idx & 1023; const float cv = (b < 32) ? c[b * 1024 + k] : cctx[k]; S[idx] = cv / (1.0f + __expf(-cv)); }
    __syncthreads();
    const int lane = tid & 63, kq = tid >> 6;
    float acc0[33], acc1[33];
#pragma unroll
    for (int b = 0; b < 33; ++b) { acc0[b] = 0.f; acc1[b] = 0.f; }
    const float* W = w_mod + (size_t)l * 1024 * 6144 + n0 + lane;
#pragma unroll 2
    for (int k = kq * 128; k < kq * 128 + 128; k += 4) {
        float wa[4], wb[4];
#pragma unroll
        for (int i = 0; i < 4; ++i) { wa[i] = __builtin_nontemporal_load(W + (size_t)(k + i) * 6144); wb[i] = __builtin_nontemporal_load(W + (size_t)(k + i) * 6144 + 64); }
#pragma unroll
        for (int b = 0; b < 33; ++b) { const f32x4 sv = *(const LAS f32x4*)(S + b * 1024 + k);
            acc0[b] += (sv[0] * wa[0] + sv[1] * wa[1]) + (sv[2] * wa[2] + sv[3] * wa[3]);
            acc1[b] += (sv[0] * wb[0] + sv[1] * wb[1]) + (sv[2] * wb[2] + sv[3] * wb[3]); }
    }
    __syncthreads();
    LAS float* red = (LAS float*)lds;
#pragma unroll
    for (int b = 0; b < 33; ++b) { red[(kq * 33 + b) * 128 + lane] = acc0[b]; red[(kq * 33 + b) * 128 + 64 + lane] = acc1[b]; }
    __syncthreads();
    for (int idx = tid; idx < 33 * 128; idx += 512) { const int b = idx >> 7, cc = idx & 127;
        float v = 0.f;
#pragma unroll
        for (int q = 0; q < 8; ++q) v += red[(q * 33 + b) * 128 + cc];
        MOD[((size_t)l * 33 + b) * 6144 + n0 + cc] = v + b_mod[l * 6144 + n0 + cc]; }
    __syncthreads();
}

DI void rope_table(LAS float* rope) {
    for (int idx = threadIdx.x; idx < 1024; idx += 512) {
        const int pos = idx >> 4, f = idx & 15;
        double fr = 1.0; const double q = 0.56234132519034908;
        for (int i = 0; i < f; ++i) fr *= q;
        const float ang = (float)pos * (float)fr;
        double r = (double)ang; const double twopi = 6.283185307179586476925;
        const double kk = __builtin_rint(r * (1.0 / twopi)); r -= kk * twopi;
        const double r2 = r * r; double s = r, ts = r, cc = 1.0, tc = 1.0;
#pragma unroll
        for (int n = 1; n <= 14; ++n) { ts *= r2 * (-1.0 / (double)((2 * n) * (2 * n + 1))); s += ts; tc *= r2 * (-1.0 / (double)((2 * n - 1) * (2 * n))); cc += tc; }
        rope[idx * 2] = (float)cc; rope[idx * 2 + 1] = (float)s;
    }
}

DI float wave_sum(float v) {
#pragma unroll
    for (int o = 1; o < 64; o <<= 1) v += __shfl_xor(v, o);
    return v;
}
struct RowArgs {
    const float* xinL; const float* xinC; float* xoutL; float* xoutC;
    const bf16_t* Y; const float* PART; const float* gate; const float* gpost;
    const bf16_t* Y2; const float* PART2; const float* gate2; const float* gpost2;
    bf16_t* H; const float* gpre; const float* sh; const float* sc;
    int M; int upd; int upd2; int wr; int nxt; int xin16; int xout16;
};
template <int NR>
DI void row_work(const RowArgs& a, int row0, int lane) {
    const int gq = row0 / GROWS, rl0 = row0 - gq * GROWS; const bool lat = rl0 < GLAT;
    const int bb = lat ? (16 * gq + (rl0 >> 11)) : 32;
    const size_t xrow0 = lat ? (size_t)(gq * GLAT + rl0) : (size_t)(gq * 4096 + rl0 - GLAT);
    const float* xi0 = (lat ? a.xinL : a.xinC) + xrow0 * 1024;
    f32x4 x[NR][4];
    if (a.xin16) {
#pragma unroll
        for (int r = 0; r < NR; ++r)
#pragma unroll
            for (int j = 0; j < 4; ++j) { const u32x2 xb = __builtin_nontemporal_load((const u32x2*)((const bf16_t*)(xi0 + (size_t)r * 1024) + 4 * lane + 256 * j));
                x[r][j] = (f32x4){bflo(xb.x), bfhi(xb.x), bflo(xb.y), bfhi(xb.y)}; }
    } else {
#pragma unroll
        for (int r = 0; r < NR; ++r)
#pragma unroll
            for (int j = 0; j < 4; ++j) x[r][j] = __builtin_nontemporal_load((const f32x4*)(xi0 + (size_t)r * 1024 + 4 * lane + 256 * j));
    }
#pragma unroll
    for (int br = 0; br < 2; ++br) {
        if (br == 0 ? !a.upd : !a.upd2) continue;
        const bf16_t* Yp = (br == 0 ? a.Y : a.Y2) + (size_t)row0 * 1024 + 4 * lane; const float* Pp = (br == 0 ? a.PART : a.PART2) + (size_t)row0 * 16 + (lane & 15);
        const float* gatep = (br == 0 ? a.gate : a.gate2) + (size_t)bb * 6144 + 4 * lane; const float* gpostp = (br == 0 ? a.gpost : a.gpost2) + 4 * lane;
        u32x2 yb[NR][4]; float ps[NR];
#pragma unroll
        for (int r = 0; r < NR; ++r) {
#pragma unroll
            for (int j = 0; j < 4; ++j) yb[r][j] = __builtin_nontemporal_load((const u32x2*)(Yp + (size_t)r * 1024 + 256 * j));
            ps[r] = Pp[r * 16];
        }
        float rstd[NR];
#pragma unroll
        for (int r = 0; r < NR; ++r) {
            float ss = ps[r]; ss += __shfl_xor(ss, 1); ss += __shfl_xor(ss, 2); ss += __shfl_xor(ss, 4); ss += __shfl_xor(ss, 8);
            rstd[r] = rsqrtf(ss * (1.0f / 1024.0f) + EPS);
        }
#pragma unroll
        for (int j = 0; j < 4; ++j) {
            const f32x4 gsc = *(const f32x4*)(gpostp + 256 * j) * *(const f32x4*)(gatep + 256 * j);
#pragma unroll
            for (int r = 0; r < NR; ++r) {
                const f32x4 y = {bflo(yb[r][j].x), bfhi(yb[r][j].x), bflo(yb[r][j].y), bfhi(yb[r][j].y)};
                x[r][j] = x[r][j] + gsc * (y * rstd[r]);
            }
        }
    }
    if (a.wr) {
        float* xo0 = (lat ? a.xoutL : a.xoutC) + xrow0 * 1024;
        if (a.xout16) {
#pragma unroll
            for (int r = 0; r < NR; ++r)
#pragma unroll
                for (int j = 0; j < 4; ++j) { u32x2 w; w.x = cvtpk(x[r][j][0], x[r][j][1]); w.y = cvtpk(x[r][j][2], x[r][j][3]);
                    __builtin_nontemporal_store(w, (u32x2*)((bf16_t*)(xo0 + (size_t)r * 1024) + 4 * lane + 256 * j)); }
        } else {
#pragma unroll
            for (int r = 0; r < NR; ++r)
#pragma unroll
                for (int j = 0; j < 4; ++j) __builtin_nontemporal_store(x[r][j], (f32x4*)(xo0 + (size_t)r * 1024 + 4 * lane + 256 * j));
        }
    }
    if (a.nxt) {
        float rstd2[NR];
#pragma unroll
        for (int r = 0; r < NR; ++r) {
            float s2 = 0.f;
#pragma unroll
            for (int j = 0; j < 4; ++j) s2 += (x[r][j][0] * x[r][j][0] + x[r][j][1] * x[r][j][1]) + (x[r][j][2] * x[r][j][2] + x[r][j][3] * x[r][j][3]);
            s2 = wave_sum(s2);
            rstd2[r] = rsqrtf(s2 * (1.0f / 1024.0f) + EPS);
        }
        const float* shp = a.sh + (size_t)bb * 6144 + 4 * lane; const float* scp = a.sc + (size_t)bb * 6144 + 4 * lane; const float* gp = a.gpre + 4 * lane;
        bf16_t* hp = a.H + (size_t)row0 * 1024 + 4 * lane;
#pragma unroll
        for (int j = 0; j < 4; ++j) {
            const f32x4 gm = *(const f32x4*)(gp + 256 * j) * (*(const f32x4*)(scp + 256 * j) + 1.0f), sv = *(const f32x4*)(shp + 256 * j);
#pragma unroll
            for (int r = 0; r < NR; ++r) {
                const f32x4 h = (x[r][j] * rstd2[r]) * gm + sv;
                u32x2 w; w.x = cvtpk(h[0], h[1]); w.y = cvtpk(h[2], h[3]);
                *(u32x2*)(hp + (size_t)r * 1024 + 256 * j) = w;
            }
        }
    }
}
DI void row_phase(const RowArgs& a, int gw, int ngw, int g) {
    int lane = threadIdx.x & 63; asm volatile("" : "+v"(lane));
    for (int rl = gw * 4; rl < a.M; rl += ngw * 4) {
        const int row = g * GROWS + rl;
        row_work<4>(a, row, lane);
    }
}

constexpr int AT_KB = 64 * 144, AT_VB = 64 * 144;
#define MFMA32(a, b, c) __builtin_amdgcn_mfma_f32_32x32x16_bf16((a), (b), (c), 0, 0, 0)
DI float swap_max(float m) { auto rr = __builtin_amdgcn_permlane32_swap(__float_as_uint(m), __float_as_uint(m), false, false); return fmaxf(__uint_as_float(rr[0]), __uint_as_float(rr[1])); }
DI float swap_sum(float m) { auto rr = __builtin_amdgcn_permlane32_swap(__float_as_uint(m), __float_as_uint(m), false, false); return __uint_as_float(rr[0]) + __uint_as_float(rr[1]); }
template <bool WINDOW, bool SINK, bool FIXED = false>
DI void attn_unit(LAS unsigned char* lds, const bf16_t* Qp, int qw, const bf16_t* Kb, int kvw, const bf16_t* Vb, bf16_t* Op,
                  int a_lo, int na, int qpos0, float sink2, float ref = 0.f) {
    int tid_ = threadIdx.x; asm volatile("" : "+v"(tid_));
    const int tid = tid_, lane = tid & 63, r32 = lane & 31, hi = lane >> 5; const int wid = __builtin_amdgcn_readfirstlane(tid >> 6);
    bf16x8 qf[4];
    { const bf16_t* qr = Qp + (size_t)(wid * 32 + r32) * qw + 8 * hi;
#pragma unroll
      for (int s = 0; s < 4; ++s) qf[s] = *(const bf16x8*)(qr + 16 * s); }
    constexpr float THR = 8.0f;
    float mhat = FIXED ? ref : (SINK ? sink2 : 0.f);
    float lrun = (SINK && hi == 0) ? (FIXED ? __builtin_amdgcn_exp2f(sink2 - ref) : 1.f) : 0.f;
    f32x16 o0, o1, negm;
#pragma unroll
    for (int i = 0; i < 16; ++i) { o0[i] = 0.f; o1[i] = 0.f; negm[i] = -mhat; }
    const int srow = tid >> 3, sch = tid & 7;
    const int ntiles = na + 4;
    const int qw0 = qpos0 + wid * 32;
    const int qpos = qw0 + r32;
#define AT_KEY(tt) ((((tt) < na) ? (a_lo + (tt)) : (32 + (tt) - na)) * 64)
#define AT_SKIP(tt) (WINDOW && (tt) < na && (((a_lo + (tt)) * 64 + 63 < qw0 - 128) || ((a_lo + (tt)) * 64 > qw0 + 159)))
#define AT_LDK(key0) (*(const u32x4*)(Kb + (size_t)((key0) + srow) * kvw + sch * 8))
#define AT_LDV(key0) (*(const u32x4*)(Vb + (size_t)srow * KVR + (key0) + sch * 8))
#define AT_STK(buf, reg) (*(LAS u32x4*)(lds + (buf) * AT_KB + srow * 144 + sch * 16) = (reg))
#define AT_STV(buf, reg) (*(LAS u32x4*)(lds + 2 * AT_KB + (buf) * AT_VB + srow * 144 + sch * 16) = (reg))
#define AT_KRD(KL) do { _Pragma("unroll") for (int s_ = 0; s_ < 4; ++s_) { kf[2 * s_] = *(const LAS bf16x8*)((KL) + r32 * 144 + (16 * s_ + 8 * hi) * 2); \
        kf[2 * s_ + 1] = *(const LAS bf16x8*)((KL) + (32 + r32) * 144 + (16 * s_ + 8 * hi) * 2); } __builtin_amdgcn_sched_barrier(0); } while (0)
#define AT_QK(S0, S1, KL, s) do { \
        if ((s) == 0) { S0 = MFMA32(kf[0], qf[0], negm); S1 = MFMA32(kf[1], qf[0], negm); } else { S0 = MFMA32(kf[2 * (s)], qf[s], S0); S1 = MFMA32(kf[2 * (s) + 1], qf[s], S1); } } while (0)
#define AT_SUM(P, sq) do { lacc += ((P[8 * (sq) + 0] + P[8 * (sq) + 1]) + (P[8 * (sq) + 2] + P[8 * (sq) + 3])) + ((P[8 * (sq) + 4] + P[8 * (sq) + 5]) + (P[8 * (sq) + 6] + P[8 * (sq) + 7])); } while (0)
#define AT_VRD(VL) do { _Pragma("unroll") for (int ks_ = 0; ks_ < 4; ++ks_) { const int koff_ = (32 * (ks_ >> 1) + 16 * (ks_ & 1) + 8 * hi) * 2; \
        vf[2 * ks_] = *(const LAS bf16x8*)((VL) + r32 * 144 + koff_); vf[2 * ks_ + 1] = *(const LAS bf16x8*)((VL) + (32 + r32) * 144 + koff_); } __builtin_amdgcn_sched_barrier(0); } while (0)
#define AT_PV(VL, ks, P, sq) do { \
        u32x4 w_; w_.x = cvtpk(P[8 * (sq) + 0], P[8 * (sq) + 1]); w_.y = cvtpk(P[8 * (sq) + 2], P[8 * (sq) + 3]); w_.z = cvtpk(P[8 * (sq) + 4], P[8 * (sq) + 5]); w_.w = cvtpk(P[8 * (sq) + 6], P[8 * (sq) + 7]); \
        const bf16x8 pb_ = __builtin_bit_cast(bf16x8, w_); \
        o0 = MFMA32(vf[2 * (ks)], pb_, o0); o1 = MFMA32(vf[2 * (ks) + 1], pb_, o1); } while (0)
#define AT_EXP8(D, Sx, sq) do { _Pragma("unroll") for (int e_ = 0; e_ < 8; ++e_) D[8 * (sq) + e_] = __builtin_amdgcn_exp2f(Sx[8 * (sq) + e_]); } while (0)
#define AT_MASK(S0, S1, tt) do { \
        if (WINDOW && (tt) < na) { const int k0_ = (a_lo + (tt)) * 64; \
            if (!((k0_ >= qw0 + 31 - 128) && (k0_ + 63 <= qw0 + 128))) { const int x_ = qpos - k0_ - 4 * hi + 128; \
            _Pragma("unroll") for (int i = 0; i < 16; ++i) { const int c_ = (i & 3) + 8 * (i >> 2); \
                if ((unsigned)(x_ - c_) > 256u) S0[i] = -INFINITY; if ((unsigned)(x_ - c_ - 32) > 256u) S1[i] = -INFINITY; } } } } while (0)
#define AT_DECIDE(S0, S1, tt, FORCE) do { \
        if (WINDOW && (tt) < na) { const int k0_ = (a_lo + (tt)) * 64; \
            if (!((k0_ >= qw0 + 31 - 128) && (k0_ + 63 <= qw0 + 128))) { const int x_ = qpos - k0_ - 4 * hi + 128; \
            _Pragma("unroll") for (int i = 0; i < 16; ++i) { const int c_ = (i & 3) + 8 * (i >> 2); \
                if ((unsigned)(x_ - c_) > 256u) S0[i] = -INFINITY; if ((unsigned)(x_ - c_ - 32) > 256u) S1[i] = -INFINITY; } } } \
        float rm_ = fmaxf(S0[0], S1[0]); \
        _Pragma("unroll") for (int i = 1; i < 16; ++i) rm_ = fmaxf(fmaxf(rm_, S0[i]), S1[i]); \
        rm_ = swap_max(rm_); \
        const bool trig_ = (FORCE) || (rm_ > THR); \
        if (__builtin_amdgcn_ballot_w64(trig_) != 0ull) { \
            const float dl_ = (FORCE) ? rm_ : fmaxf(rm_, 0.f); mhat += dl_; \
            _Pragma("unroll") for (int i = 0; i < 16; ++i) { S0[i] -= dl_; S1[i] -= dl_; } \
            _Pragma("unroll") for (int i = 0; i < 16; ++i) negm[i] = -mhat; \
            fsave = __builtin_amdgcn_exp2f(-dl_); lrun *= fsave; resc = true; } } while (0)

    u32x4 kreg, vreg;
    kreg = AT_LDK(AT_KEY(0));
    AT_STK(0, kreg);
    kreg = AT_LDK(AT_KEY(1)); vreg = AT_LDV(AT_KEY(0));
    __syncthreads();
    f32x16 sn0, sn1, pc0, pc1;
    bf16x8 kf[8], vf[8];
    float fsave = 1.f; bool resc = false;
    bool have_cur = !AT_SKIP(0);
    if (have_cur) {
        const LAS unsigned char* Kl = lds;
        AT_KRD(Kl);
        AT_QK(sn0, sn1, Kl, 0); AT_QK(sn0, sn1, Kl, 1); AT_QK(sn0, sn1, Kl, 2); AT_QK(sn0, sn1, Kl, 3);
        if (!FIXED) { AT_DECIDE(sn0, sn1, 0, !SINK); } else { AT_MASK(sn0, sn1, 0); }
        AT_EXP8(pc0, sn0, 0); AT_EXP8(pc0, sn0, 1); AT_EXP8(pc1, sn1, 0); AT_EXP8(pc1, sn1, 1);
        if (resc) {
#pragma unroll
            for (int i = 0; i < 16; ++i) { o0[i] *= fsave; o1[i] *= fsave; }
            resc = false; }
    }
    AT_STK(1, kreg); AT_STV(0, vreg);
    __syncthreads();
#define AT_ITER(t, DD, KLD, VLD, KST, VST) do { \
        if (t + 2 + DD < ntiles) KLD = AT_LDK(AT_KEY(t + 2 + DD)); \
        if (t + 1 + DD < ntiles) VLD = AT_LDV(AT_KEY(t + 1 + DD)); \
        const bool have_next = (t + 1 < ntiles) && !AT_SKIP(t + 1); \
        const LAS unsigned char* Kl = lds + ((t + 1) & 1) * AT_KB; \
        const LAS unsigned char* Vl = lds + 2 * AT_KB + (t & 1) * AT_VB; \
        float lacc = 0.f; \
        if (have_cur && have_next) { \
            AT_KRD(Kl); \
            AT_QK(sn0, sn1, Kl, 0); AT_SUM(pc0, 0); \
            AT_QK(sn0, sn1, Kl, 1); AT_SUM(pc0, 1); \
            AT_QK(sn0, sn1, Kl, 2); AT_SUM(pc1, 0); \
            AT_QK(sn0, sn1, Kl, 3); AT_SUM(pc1, 1); \
            lrun += lacc; \
            __builtin_amdgcn_sched_barrier(0); \
            AT_VRD(Vl); \
            if (!FIXED) { AT_DECIDE(sn0, sn1, t + 1, false); } else { AT_MASK(sn0, sn1, t + 1); } \
            AT_PV(Vl, 0, pc0, 0); AT_EXP8(pc0, sn0, 0); \
            AT_PV(Vl, 1, pc0, 1); AT_EXP8(pc0, sn0, 1); \
            AT_PV(Vl, 2, pc1, 0); AT_EXP8(pc1, sn1, 0); \
            AT_PV(Vl, 3, pc1, 1); AT_EXP8(pc1, sn1, 1); \
        } else { \
            if (have_cur) { AT_SUM(pc0, 0); AT_SUM(pc0, 1); AT_SUM(pc1, 0); AT_SUM(pc1, 1); lrun += lacc; } \
            if (have_next) { AT_KRD(Kl); AT_QK(sn0, sn1, Kl, 0); AT_QK(sn0, sn1, Kl, 1); AT_QK(sn0, sn1, Kl, 2); AT_QK(sn0, sn1, Kl, 3); if (!FIXED) { AT_DECIDE(sn0, sn1, t + 1, false); } else { AT_MASK(sn0, sn1, t + 1); } } \
            if (have_cur) { AT_VRD(Vl); AT_PV(Vl, 0, pc0, 0); AT_PV(Vl, 1, pc0, 1); AT_PV(Vl, 2, pc1, 0); AT_PV(Vl, 3, pc1, 1); } \
            if (have_next) { AT_EXP8(pc0, sn0, 0); AT_EXP8(pc0, sn0, 1); AT_EXP8(pc1, sn1, 0); AT_EXP8(pc1, sn1, 1); } \
        } \
        if (resc) { \
            _Pragma("unroll") \
            for (int i = 0; i < 16; ++i) { o0[i] *= fsave; o1[i] *= fsave; } \
            resc = false; } \
        if (t + 2 < ntiles) AT_STK(t & 1, KST); \
        if (t + 1 < ntiles) AT_STV((t + 1) & 1, VST); \
        __syncthreads(); \
        have_cur = have_next; \
    } while (0)
    if constexpr (!WINDOW) {
        u32x4 kreg2, vreg2;
        if (ntiles > 2) kreg2 = AT_LDK(AT_KEY(2));
        vreg2 = AT_LDV(AT_KEY(1));
        for (int t2 = 0; t2 < ntiles; t2 += 2) {
            { const int t = t2; AT_ITER(t, 1, kreg, vreg, kreg2, vreg2); }
            { const int t = t2 + 1; AT_ITER(t, 1, kreg2, vreg2, kreg, vreg); }
        }
    } else {
        for (int t = 0; t < ntiles; ++t) { AT_ITER(t, 0, kreg, vreg, kreg, vreg); }
    }
#undef AT_ITER
#undef AT_KEY
#undef AT_SKIP
#undef AT_LDK
#undef AT_LDV
#undef AT_STK
#undef AT_STV
#undef AT_QK
#undef AT_KRD
#undef AT_VRD
#undef AT_SUM
#undef AT_PV
#undef AT_EXP8
#undef AT_DECIDE
#undef AT_MASK
    const float lt = swap_sum(lrun);
    const float inv = 1.0f / lt;
    bf16_t* orow = Op + (size_t)(wid * 32 + r32) * 1024 + 4 * hi;
#pragma unroll
    for (int g = 0; g < 4; ++g) {
        u32x2 w0, w1;
        w0.x = cvtpk(o0[4 * g + 0] * inv, o0[4 * g + 1] * inv); w0.y = cvtpk(o0[4 * g + 2] * inv, o0[4 * g + 3] * inv);
        w1.x = cvtpk(o1[4 * g + 0] * inv, o1[4 * g + 1] * inv); w1.y = cvtpk(o1[4 * g + 2] * inv, o1[4 * g + 3] * inv);
        *(u32x2*)(orow + 8 * g) = w0; *(u32x2*)(orow + 32 + 8 * g) = w1;
    }
}

template <int GI>
DI void pool_unit_t(int rt, const bf16_t* U, const bf16_t* WpT, const float* pscale, bf16_t* MIX) {
    constexpr int g = GI, w = 2 << GI, hw = w >> 1;
    int tid_ = threadIdx.x; asm volatile("" : "+v"(tid_));
    const int tid = tid_, lane = tid & 63, fr = lane & 15, fq = lane >> 4; const int wid = __builtin_amdgcn_readfirstlane(tid >> 6);
    const int row = rt * 128 + wid * 16 + fr;
    const int rlq = row % GROWS;
    const bool lat = rlq < GLAT;
    const int t = lat ? (rlq & (SEQ - 1)) : ((rlq - GLAT) & (CTX - 1));
    const int S = lat ? SEQ : CTX;
    const int base = row - t;
    const int lo = (t - hw) < 0 ? 0 : (t - hw), hi = (t + hw) > S ? S : (t + hw);
    const float icnt = 1.0f / (float)(hi - lo);
    bf16x8 af[4];
#pragma unroll
    for (int ks = 0; ks < 4; ++ks) {
        const int c0 = g * 128 + 32 * ks + 8 * fq;
        u32x4 uv[w];
#pragma unroll
        for (int j = 0; j < w; ++j) {
            const int p = t - hw + j; const bool ok = (p >= 0 && p < S);
            uv[j] = *(const u32x4*)(U + (size_t)(base + (ok ? p : t)) * 512 + c0);
        }
        const u32x4 us = *(const u32x4*)(U + (size_t)row * 512 + c0);
        float sum[8];
#pragma unroll
        for (int e = 0; e < 8; ++e) sum[e] = 0.f;
#pragma unroll
        for (int j = 0; j < w; ++j) {
            const int p = t - hw + j; const float wt = (p >= 0 && p < S) ? 1.0f : 0.0f;
            sum[0] += wt * bflo(uv[j].x); sum[1] += wt * bfhi(uv[j].x); sum[2] += wt * bflo(uv[j].y); sum[3] += wt * bfhi(uv[j].y);
            sum[4] += wt * bflo(uv[j].z); sum[5] += wt * bfhi(uv[j].z); sum[6] += wt * bflo(uv[j].w); sum[7] += wt * bfhi(uv[j].w);
        }
        const float u0 = bflo(us.x), u1 = bfhi(us.x), u2 = bflo(us.y), u3 = bfhi(us.y), u4 = bflo(us.z), u5 = bfhi(us.z), u6 = bflo(us.w), u7 = bfhi(us.w);
        u32x4 d; d.x = cvtpk(sum[0] * icnt - u0, sum[1] * icnt - u1); d.y = cvtpk(sum[2] * icnt - u2, sum[3] * icnt - u3);
        d.z = cvtpk(sum[4] * icnt - u4, sum[5] * icnt - u5); d.w = cvtpk(sum[6] * icnt - u6, sum[7] * icnt - u7);
        af[ks] = __builtin_bit_cast(bf16x8, d);
    }
    const bf16_t* wp = WpT + (size_t)g * 128 * 128;
#pragma unroll
    for (int nt = 0; nt < 8; ++nt) {
        f32x4 acc = {0.f, 0.f, 0.f, 0.f};
#pragma unroll
        for (int ks = 0; ks < 4; ++ks) {
            const bf16x8 bfrag = *(const bf16x8*)(wp + (size_t)(16 * nt + fr) * 128 + 32 * ks + 8 * fq);
            acc = __builtin_amdgcn_mfma_f32_16x16x32_bf16(bfrag, af[ks], acc, 0, 0, 0);
        }
        const int n = g * 128 + 16 * nt + 4 * fq;
        const f32x4 ps = *(const f32x4*)(pscale + n);
        u32x2 w2; w2.x = cvtpk(acc[0] * ps[0], acc[1] * ps[1]); w2.y = cvtpk(acc[2] * ps[2], acc[3] * ps[3]);
        *(u32x2*)(MIX + (size_t)row * 1024 + 512 + n) = w2;
    }
}
DI void pool_unit(int rt, int g, const bf16_t* U, const bf16_t* WpT, const float* pscale, bf16_t* MIX) {
    if (g == 0) pool_unit_t<0>(rt, U, WpT, pscale, MIX);
    else if (g == 1) pool_unit_t<1>(rt, U, WpT, pscale, MIX);
    else if (g == 2) pool_unit_t<2>(rt, U, WpT, pscale, MIX);
    else pool_unit_t<3>(rt, U, WpT, pscale, MIX);
}

#define XB_TMO      128
#define XB_XCNT(j)  (256  + 64 * (j))
#define XB_XSUB(j)  (1280 + 64 * (j))
#define XB_XGEN(j)  (2304 + 64 * (j))
#define XB_TOP      3328
#define XB_TOPGEN   3392
#define XCD_BAR_WORDS 3456
#define XB_SPIN_CAP (1u << 18)
__device__ __forceinline__ unsigned xb_ld(unsigned* p)              { return __hip_atomic_load(p, __ATOMIC_RELAXED, __HIP_MEMORY_SCOPE_AGENT); }
__device__ __forceinline__ unsigned xb_add(unsigned* p, unsigned v) { return __hip_atomic_fetch_add(p, v, __ATOMIC_RELAXED, __HIP_MEMORY_SCOPE_AGENT); }
__device__ __forceinline__ unsigned xb_xcc_id() { return (unsigned)__builtin_amdgcn_s_getreg((3 << 11) | 20) & 0xFu; }
#define XB_SPIN(cond, bar) do { unsigned _sp = 0; while (cond) { __builtin_amdgcn_s_sleep(1); \
    if ((++_sp & 255u) == 0u) { if (xb_ld(&(bar)[XB_TMO])) break; if (_sp > XB_SPIN_CAP) { atomicAdd(&(bar)[XB_TMO], 1u); break; } } } } while (0)
struct XcdBarrier { unsigned* bar; unsigned x; volatile LAS unsigned* st; unsigned gsize; };
__device__ __forceinline__ XcdBarrier xcd_barrier_post(unsigned* bar, volatile LAS unsigned* st, unsigned gsize) {
    XcdBarrier b; b.bar = bar; b.x = xb_xcc_id(); b.st = st; b.gsize = gsize;
    if (threadIdx.x == 0) (void)xb_add(&bar[XB_XCNT(b.x)], 1u);
    return b;
}
__device__ __forceinline__ void xcd_barrier_complete(unsigned* bar, unsigned x, unsigned G, unsigned& nloc, unsigned& nx) {
    unsigned sum, cnt, mine, sp = 0u;
    for (;;) {
        sum = 0u; cnt = 0u; mine = 0u;
#pragma unroll
        for (unsigned j = 0; j < 16; ++j) { const unsigned c = xb_ld(&bar[XB_XCNT(j)]); sum += c; cnt += (c > 0u) ? 1u : 0u; mine = (j == x) ? c : mine; }
        if (sum == G) break;
        __builtin_amdgcn_s_sleep(1);
        if ((++sp & 255u) == 0u) { if (xb_ld(&bar[XB_TMO])) break; if (sp > XB_SPIN_CAP) { atomicAdd(&bar[XB_TMO], 1u); break; } }
    }
    nloc = mine > 0u ? mine : 1u; nx = cnt > 0u ? cnt : 1u;
}
__device__ __forceinline__ void xcd_barrier(const XcdBarrier& b) {
    asm volatile("s_waitcnt vmcnt(0)" ::: "memory");
    __syncthreads();
    if (threadIdx.x == 0) {
        unsigned* bar = b.bar; asm volatile("" : "+s"(bar));
        unsigned bx_ = b.x; asm volatile("" : "+s"(bx_));
        __builtin_amdgcn_s_waitcnt(0);
        unsigned nloc = b.st[0], nx = b.st[1];
        if (nloc == 0u) { xcd_barrier_complete(bar, bx_, b.gsize, nloc, nx); b.st[0] = nloc; b.st[1] = nx; }
        const unsigned old = xb_add(&bar[XB_XSUB(bx_)], 1u);
        const unsigned gen = old / nloc;
        if (old + 1u == (gen + 1u) * nloc) {
            __builtin_amdgcn_fence(__ATOMIC_RELEASE, "agent");
            asm volatile("s_waitcnt vmcnt(0)" ::: "memory");
            const unsigned og = xb_add(&bar[XB_TOP], 1u);
            const unsigned tg = og / nx;
            if (og + 1u == (tg + 1u) * nx) xb_add(&bar[XB_TOPGEN], 1u);
            else XB_SPIN(xb_ld(&bar[XB_TOPGEN]) == tg, bar);
            __builtin_amdgcn_fence(__ATOMIC_ACQUIRE, "agent");
            xb_add(&bar[XB_XGEN(bx_)], 1u);
            asm volatile("s_waitcnt vmcnt(0)" ::: "memory");
        } else {
            XB_SPIN(xb_ld(&bar[XB_XGEN(bx_)]) == gen, bar);
            __builtin_amdgcn_fence(__ATOMIC_ACQUIRE, "agent");
            asm volatile("s_waitcnt vmcnt(0)" ::: "memory");
        }
    }
    __syncthreads();
}

struct Args { const float* in[21]; float* out; unsigned char* ws; int never; int pad; };
constexpr size_t CTL_FLAG = 31744;
constexpr int STAGGER_SPIN = 0;

__global__ void __launch_bounds__(512, 2) fwd_megakernel(Args args) {
    extern __shared__ __attribute__((aligned(16))) unsigned char lds_raw[];
    LAS unsigned char* lds = (LAS unsigned char*)lds_raw;
    cg::grid_group grid = cg::this_grid();
    const int tid = threadIdx.x; const int wave = __builtin_amdgcn_readfirstlane(tid >> 6);
    const int G = gridDim.x, bx = blockIdx.x;
    const int grp = (bx >> 3) & 1, c = ((bx >> 4) << 3) | (bx & 7), Gg = G >> 1;
    volatile LAS unsigned* xst = (volatile LAS unsigned*)(lds + LDS_BYTES - 16);
    if (tid < 4) xst[tid] = 0u;
    __syncthreads();
    XcdBarrier xbar = xcd_barrier_post((unsigned*)args.ws + grp * 4096, xst, (unsigned)Gg);
    XcdBarrier gbar = xcd_barrier_post((unsigned*)args.ws + 2 * 4096, xst + 2, (unsigned)G);
#define GBAR() xcd_barrier(xbar)
    unsigned char* ws = args.ws;
    unsigned* flagw = (unsigned*)(ws + CTL_FLAG);
    const float* x_in = args.in[0]; const float* c_in = args.in[1]; const float* ctx_in = args.in[2]; const float* cctx_in = args.in[3];
    const float* w_mod = args.in[4]; const float* b_mod = args.in[5];
    const float* g_pre_mix = args.in[6]; const float* g_post_mix = args.in[7]; const float* g_pre_ffn = args.in[8]; const float* g_post_ffn = args.in[9];
    const float* we_in = args.in[10]; const float* we_out = args.in[11]; const float* we_qg = args.in[12]; const float* we_kg = args.in[13];
    const float* we_pool = args.in[14]; const float* we_pscale = args.in[15];
    const float* wo_in = args.in[16]; const float* wo_out = args.in[17]; const float* wo_sink = args.in[18];
    const float* w_f1 = args.in[19]; const float* w_f2 = args.in[20];
    float* out = args.out;
    float* MOD = (float*)(ws + WS_MOD); float* PART = (float*)(ws + WS_PART); float* PART2 = (float*)(ws + WS_PART2); bf16_t* Y2 = (bf16_t*)(ws + WS_Y2);
    float* XC = (float*)(ws + WS_XC);
    bf16_t* H = (bf16_t*)(ws + WS_H); bf16_t* Y = (bf16_t*)(ws + WS_Y);
    unsigned char* arena = ws + WS_Q + (size_t)grp * (216 * MiB);
    bf16_t* Ub = (bf16_t*)(arena + 108 * MiB) - (size_t)grp * GROWS * 512; bf16_t* MIX = (bf16_t*)(arena + 144 * MiB) - (size_t)grp * GROWS * 1024;
    bf16_t* ACT = (bf16_t*)arena - (size_t)grp * GROWS * FFN;
    const int gw = c * 8 + wave, ngw = Gg * 8;
    const int xl = c & 7, jl = c >> 3;

    for (int it = bx; it < 4 * 48; it += G) mod_item(it, c_in, cctx_in, w_mod, b_mod, MOD, lds);
    for (int l = 0; l < NLAYER; ++l) prep_layer(l, bx, G, ws, lds, we_in, we_out, we_pool, wo_in, wo_out, w_f1, w_f2);
    if (args.never) grid.sync();
    xcd_barrier(gbar);
    {
        RowArgs a{}; a.xinL = x_in; a.xinC = ctx_in; a.H = H; a.gpre = g_pre_mix; a.sh = MOD; a.sc = MOD + 1024; a.M = 36864; a.upd = 0; a.upd2 = 0; a.wr = 0; a.nxt = 1;
        row_phase(a, gw, ngw, grp);
    }
    GBAR();
    for (int l = 0; l < NLAYER; ++l) {
        const int li = l >> 1; const bool ev = (l & 1) == 0; const bool with_ctx = l < NLAYER - 1;
        const int Mlog = with_ctx ? 36864 : 32768;
        unsigned char* wl = ws + WS_W + (size_t)l * WL_STRIDE;
        float* MODl = MOD + (size_t)l * 33 * 6144;
        bf16_t* Qb = (bf16_t*)arena - (size_t)grp * GROWS * (ev ? 512 : 1024);
        bf16_t* Kb = (bf16_t*)(arena + 72 * MiB) - (size_t)(16 * grp) * KVR * (ev ? 128 : 256);
        bf16_t* Vt = (bf16_t*)(arena + 90 * MiB) - (size_t)(16 * grp) * (ev ? 2 : 4) * 64 * KVR;
        {
            pg8::Gemm g{H, (const bf16_t*)(wl + WL_IN), 36864, ev ? 1280 : 1536, 1024}; pg8::GroupOrder S; S.init(g.M, g.N, Gg, c, grp);
            LAS float* ropel = (LAS float*)(lds + 131072);
            rope_table(ropel); __syncthreads();
            EpiQKV E{ev ? 1 : 0, Qb, Kb, Vt, Ub, we_qg + li * 64, we_kg + li * 64, ropel, ev ? (unsigned*)nullptr : (unsigned*)(ws + 49152) + li * 640};
            pg8::gemm_phase<EpiQKV, pg8::GroupOrder>(lds, g, S, E);
        }
        GBAR();
        if (ev) {
            const int n_dense = 1024, n_ctx = with_ctx ? 128 : 0;
            float bref;
            { const int ln = tid & 63; float gq = fabsf(we_qg[li * 64 + ln]), gk = fabsf(we_kg[li * 64 + ln]);
#pragma unroll
              for (int o = 1; o < 64; o <<= 1) { gq = fmaxf(gq, __shfl_xor(gq, o)); gk = fmaxf(gk, __shfl_xor(gk, o)); }
              bref = __uint_as_float(__builtin_amdgcn_readfirstlane(__float_as_uint(64.0f * C2 * gq * gk * 1.02f + 0.25f))); }
            for (int u = c; u < n_dense + n_ctx; u += Gg) {
                int b, head, qrow0, na;
                if (u < n_dense) { int qb = u & 7; head = (u >> 3) & 7; int bl = u >> 6;
                    if (Gg == 128) { const int i = u >> 7, pr = (i >> 1) * 8 + xl, idx = (i & 1) * 16 + jl; bl = pr >> 1; head = (pr & 1) * 4 + (idx >> 3); qb = idx & 7; }
                    b = 16 * grp + bl; qrow0 = grp * GROWS + bl * SEQ + qb * 256; na = 32; }
                else { const int v = u - n_dense; head = v & 7; b = 16 * grp + (v >> 3); qrow0 = grp * GROWS + GLAT + (v >> 3) * CTX; na = 0; }
                const int kvh = head >> 2;
                if (bref <= 40.0f) attn_unit<false, false, true>(lds, Qb + (size_t)qrow0 * 512 + head * 64, 512, Kb + (size_t)b * KVR * 128 + kvh * 64, 128, Vt + (size_t)(b * 2 + kvh) * 64 * KVR,
                                                              MIX + (size_t)qrow0 * 1024 + head * 64, 0, na, 0, 0.f, bref);
                else attn_unit<false, false, false>(lds, Qb + (size_t)qrow0 * 512 + head * 64, 512, Kb + (size_t)b * KVR * 128 + kvh * 64, 128, Vt + (size_t)(b * 2 + kvh) * 64 * KVR,
                                                    MIX + (size_t)qrow0 * 1024 + head * 64, 0, na, 0, 0.f);
            }
            const int n_rt = Mlog / 128, n_pool = n_rt * 4;
            for (int u = c; u < n_pool; u += Gg) { const int tl = u % n_rt; const int rt = grp * (GROWS / 128) + tl;
                pool_unit(rt, u / n_rt, Ub, (const bf16_t*)(wl + WL_POOL), we_pscale + li * 512, MIX); }
        } else {
            const int n_win = 2048, n_ctx = with_ctx ? 256 : 0;
            for (int u = c; u < n_win + n_ctx; u += Gg) {
                if (u < n_win) {
                    int qb = u & 7, head = (u >> 3) & 15, bl = u >> 7;
                    if (Gg == 128) { const int i = u >> 7, pr = (i >> 1) * 8 + xl, idx = (i & 1) * 16 + jl; bl = pr >> 2; head = (pr & 3) * 4 + (idx >> 3); qb = ((idx & 7) + (i >> 1)) & 7; }
                    const int b = 16 * grp + bl; const int q0 = qb * 256, qrow0 = grp * GROWS + bl * SEQ + q0, kvh = head >> 2;
                    const int klo = (q0 - 128) < 0 ? 0 : (q0 - 128), khi = (q0 + 384) > SEQ ? SEQ : (q0 + 384);
                    const float sk = wo_sink[li * 16 + head] * LOG2E;
                    unsigned* mwp = (unsigned*)(ws + 49152) + li * 640 + b * 20;
                    const float mq2 = __uint_as_float(__builtin_amdgcn_readfirstlane(__hip_atomic_load(mwp + head, __ATOMIC_RELAXED, __HIP_MEMORY_SCOPE_AGENT)));
                    const float mk2 = __uint_as_float(__builtin_amdgcn_readfirstlane(__hip_atomic_load(mwp + 16 + kvh, __ATOMIC_RELAXED, __HIP_MEMORY_SCOPE_AGENT)));
                    const float refw = fmaxf(sqrtf(mq2 * mk2) * 1.02f + 0.25f, sk);
                    if (refw <= 50.0f && refw - sk <= 100.0f)
                        attn_unit<true, true, true>(lds, Qb + (size_t)qrow0 * 1024 + head * 64, 1024, Kb + (size_t)b * KVR * 256 + kvh * 64, 256, Vt + (size_t)(b * 4 + kvh) * 64 * KVR,
                                                    MIX + (size_t)qrow0 * 1024 + head * 64, klo >> 6, (khi - klo) >> 6, q0, sk, refw);
                    else
                    attn_unit<true, true>(lds, Qb + (size_t)qrow0 * 1024 + head * 64, 1024, Kb + (size_t)b * KVR * 256 + kvh * 64, 256, Vt + (size_t)(b * 4 + kvh) * 64 * KVR,
                                          MIX + (size_t)qrow0 * 1024 + head * 64, klo >> 6, (khi - klo) >> 6, q0, sk);
                } else {
                    const int v = u - n_win, head = v & 15, b = 16 * grp + (v >> 4); const int qrow0 = grp * GROWS + GLAT + (v >> 4) * CTX, kvh = head >> 2;
                    const float sk = wo_sink[li * 16 + head] * LOG2E;
                    attn_unit<false, true>(lds, Qb + (size_t)qrow0 * 1024 + head * 64, 1024, Kb + (size_t)b * KVR * 256 + kvh * 64, 256, Vt + (size_t)(b * 4 + kvh) * 64 * KVR,
                                           MIX + (size_t)qrow0 * 1024 + head * 64, 0, 0, 0, sk);
                }
            }
        }
        GBAR();
        {
            pg8::Gemm g{MIX, (const bf16_t*)(wl + WL_OUT), Mlog, 1024, 1024}; pg8::GroupOrder S; S.init(g.M, g.N, Gg, c, grp);
            EpiY E{Y, PART};
            pg8::gemm_phase<EpiY, pg8::GroupOrder>(lds, g, S, E);
        }
        GBAR();
        {
            RowArgs a{}; a.xinL = (l == 0) ? x_in : out; a.xinC = (l == 0) ? ctx_in : XC; a.xoutL = out; a.xoutC = XC;
            a.Y = Y; a.PART = PART; a.gate = MODl + 2048; a.gpost = g_post_mix + l * 1024;
            a.H = H; a.gpre = g_pre_ffn + l * 1024; a.sh = MODl + 3072; a.sc = MODl + 4096; a.M = Mlog; a.upd = 1; a.upd2 = 0; a.wr = 0; a.nxt = 1; a.xin16 = (l > 0) ? 1 : 0;
            row_phase(a, gw, ngw, grp);
        }
        GBAR();
        {
            pg8::Gemm g{H, (const bf16_t*)(wl + WL_F1), Mlog, 2 * FFN, 1024}; pg8::GroupOrder S; S.init(g.M, g.N, Gg, c, grp);
            EpiSwiGLU E{ACT};
            pg8::gemm_phase<EpiSwiGLU, pg8::GroupOrder>(lds, g, S, E);
        }
        GBAR();
        {
            pg8::Gemm g{ACT, (const bf16_t*)(wl + WL_F2), Mlog, 1024, FFN}; pg8::GroupOrder S; S.init(g.M, g.N, Gg, c, grp);
            EpiY E{Y2, PART2};
            pg8::gemm_phase<EpiY, pg8::GroupOrder>(lds, g, S, E);
        }
        GBAR();
        {
            RowArgs a{}; a.xinL = (l == 0) ? x_in : out; a.xinC = (l == 0) ? ctx_in : XC; a.xoutL = out; a.xoutC = XC;
            a.Y = Y; a.PART = PART; a.gate = MODl + 2048; a.gpost = g_post_mix + l * 1024;
            a.Y2 = Y2; a.PART2 = PART2; a.gate2 = MODl + 5120; a.gpost2 = g_post_ffn + l * 1024;
            a.H = H; a.gpre = g_pre_mix + (l + 1 < NLAYER ? l + 1 : l) * 1024; a.sh = MODl + 33 * 6144; a.sc = MODl + 33 * 6144 + 1024; a.M = Mlog; a.upd = 1; a.upd2 = 1; a.wr = 1; a.nxt = with_ctx ? 1 : 0; a.xin16 = (l > 0) ? 1 : 0; a.xout16 = with_ctx ? 1 : 0;
            row_phase(a, gw, ngw, grp);
        }
        if (l + 1 < NLAYER) GBAR();
    }
#undef GBAR
}

extern "C" void kernel_launch(void* const* d_in, const int* in_sizes, int n_in, void* d_out, int out_size, void* d_ws, size_t ws_size, hipStream_t stream) {
    static int grid = 0;
    if (grid == 0) {
        if (n_in != 21 || out_size != NL * DM || ws_size < WS_END) { fprintf(stderr, "kernel_launch: unexpected shapes (n_in %d out %d ws %zu)\n", n_in, out_size, ws_size); grid = -1; return; }
        int dev = 0, cus = 0, per_cu = 0;
        (void)hipGetDevice(&dev);
        (void)hipDeviceGetAttribute(&cus, hipDeviceAttributeMultiprocessorCount, dev);
        if (hipFuncSetAttribute((const void*)fwd_megakernel, hipFuncAttributeMaxDynamicSharedMemorySize, LDS_BYTES) != hipSuccess) { fprintf(stderr, "kernel_launch: hipFuncSetAttribute failed\n"); }
        if (hipOccupancyMaxActiveBlocksPerMultiprocessor(&per_cu, (const void*)fwd_megakernel, 512, LDS_BYTES) != hipSuccess || per_cu < 1) { fprintf(stderr, "kernel_launch: occupancy query says %d\n", per_cu); per_cu = 1; }
        (void)hipGetLastError();
        if (per_cu > 1) per_cu = 1;
        grid = (cus * per_cu) & ~1;
    }
    if (grid < 0) return;
    if (hipMemsetAsync(d_ws, 0, 57344, stream) != hipSuccess) { fprintf(stderr, "kernel_launch: memset of barrier words failed\n"); return; }
    Args a{};
    for (int i = 0; i < 21; ++i) a.in[i] = (const float*)d_in[i];
    a.out = (float*)d_out; a.ws = (unsigned char*)d_ws;
    void* kargs[] = {&a};
    hipError_t e = hipLaunchCooperativeKernel((const void*)fwd_megakernel, dim3(grid), dim3(512), kargs, LDS_BYTES, stream);
    if (e != hipSuccess) fprintf(stderr, "cooperative launch failed: %s (grid %d)\n", hipGetErrorString(e), grid);
}
```

```cpp
#include <hip/hip_runtime.h>
#include <hip/hip_cooperative_groups.h>
#include <cstdio>
#include <cstdint>
namespace cg = cooperative_groups;

#define DI __device__ __forceinline__
#define LAS __attribute__((address_space(3)))
typedef unsigned short bf16_t;
typedef short bf16x8 __attribute__((ext_vector_type(8)));
typedef short s16x4 __attribute__((ext_vector_type(4)));
typedef float f32x4 __attribute__((ext_vector_type(4)));
typedef float f32x16 __attribute__((ext_vector_type(16)));
typedef unsigned u32x4 __attribute__((ext_vector_type(4)));
typedef unsigned u32x2 __attribute__((ext_vector_type(2)));
typedef float f32x2_t __attribute__((ext_vector_type(2)));
typedef __bf16 bf16x2_t __attribute__((ext_vector_type(2)));

DI unsigned cvtpk(float lo, float hi) { f32x2_t v = {lo, hi}; bf16x2_t b = __builtin_convertvector(v, bf16x2_t); return __builtin_bit_cast(unsigned, b); }
DI float bf2f(unsigned short b) { return __uint_as_float(((unsigned)b) << 16); }
DI float bflo(unsigned w) { return __uint_as_float(w << 16); }
DI float bfhi(unsigned w) { return __uint_as_float(w & 0xffff0000u); }

constexpr int DM = 1024, NBATCH = 32, SEQ = 2048, CTX = 256, NLAYER = 4;
constexpr int NL = NBATCH * SEQ;
constexpr int NC = NBATCH * CTX;
constexpr int NT = NL + NC;
constexpr int GROWS = 36864, GLAT = 32768, GPAN = 144;
constexpr int KVR = SEQ + CTX;
constexpr int FFN = 2816;
constexpr float EPS = 1e-6f;
constexpr float LOG2E = 1.4426950408889634f;
constexpr float C2 = 0.125f * LOG2E;

constexpr size_t MiB = 1u << 20;
constexpr size_t WS_MOD = 1 * MiB;
constexpr size_t WS_ROPE = 5 * MiB;
constexpr size_t WS_PART = 6 * MiB;
constexpr size_t WS_PART2 = 11 * MiB;
constexpr size_t WS_W = 16 * MiB;
constexpr size_t WL_IN = 0, WL_OUT = 3 * MiB, WL_POOL = 5 * MiB, WL_F1 = 6 * MiB, WL_F2 = 17 * MiB, WL_STRIDE = 24 * MiB;
constexpr size_t WS_XC = 112 * MiB;
constexpr size_t WS_H = 144 * MiB;
constexpr size_t WS_Y = 288 * MiB;
constexpr size_t WS_Q = 432 * MiB;
constexpr size_t WS_K = 576 * MiB;
constexpr size_t WS_VT = 612 * MiB;
constexpr size_t WS_U = 648 * MiB;
constexpr size_t WS_MIX = 720 * MiB;
constexpr size_t WS_ACT = 432 * MiB;
constexpr size_t WS_Y2 = 864 * MiB;
constexpr size_t WS_END = 1008 * MiB;
constexpr int LDS_BYTES = 147456;

namespace pg8 {
#define PG8_LAS __attribute__((address_space(3)))
constexpr int BM = 256, BK = 64, HALF = 128, HTB = HALF * BK * 2, STAGE_BYTES = 8 * HTB, NXCD = 8, WGM = 4;
__host__ __device__ __forceinline__ int lds_byte(int r, int c) { const int st = (r >> 4) * 2 + (c >> 5), rr = r & 15, cc = c & 31, ob = rr * 64 + cc * 2; return st * 1024 + (ob ^ (((ob >> 9) & 1) << 5)); }
__host__ __device__ __forceinline__ void stage_rc(int b, int& R, int& C) { const int st = b / 1024, sb = b % 1024, swz = sb ^ (((sb >> 9) & 1) << 5); R = (st >> 1) * 16 + swz / 64; C = (st & 1) * 32 + (swz % 64) / 2; }
struct Unit { int pm, pn; };
struct Gemm { const bf16_t* A; const bf16_t* Bt; int M, N, K; };
struct StaticOrder {
    int nM, nN, nwg, G, c;
    __host__ __device__ void init(int M, int N, int G_, int c_) { nM = M / BM; nN = N / BM; nwg = nM * nN; G = G_; c = c_; }
    __host__ __device__ bool next(int i, Unit& u) const {
        const long L = (long)i * G + c; if (L >= nwg) return false;
        int wgid = (int)L; { const int q = nwg / NXCD, r = nwg % NXCD, xcd = wgid % NXCD, off = wgid / NXCD; wgid = (xcd < r ? xcd * (q + 1) : r * (q + 1) + (xcd - r) * q) + off; }
        const int nig = WGM * nN, gid = wgid / nig, fm = gid * WGM, gsz = (nM - fm) < WGM ? (nM - fm) : WGM;
        u.pm = fm + ((wgid % nig) % gsz); u.pn = (wgid % nig) / gsz; return true;
    }
};
struct GroupOrder {
    StaticOrder base; int g;
    __host__ __device__ void init(int Mlog, int N, int Gg, int c, int g_) { base.init(Mlog, N, Gg, c); g = g_; }
    __host__ __device__ bool next(int i, Unit& u) const {
        if (!base.next(i, u)) return false;
        u.pm += 144 * g; return true;
    }
};
template <class Epi, class Sched>
__device__ __forceinline__ void gemm_phase(PG8_LAS unsigned char* lds, const Gemm g, const Sched& S, const Epi& E) {
    int tid_ = threadIdx.x; asm volatile("" : "+v"(tid_));
    const int tid = tid_, wid = __builtin_amdgcn_readfirstlane(tid >> 6), lane = tid & 63, wr = wid >> 2, wc = wid & 3, fr = lane & 15, fq = lane >> 4;
    const int K = g.K, nt = K / BK;
    unsigned voffA[2], voffB[2];
#pragma unroll
    for (int i = 0; i < 2; ++i) { int R, C; stage_rc(tid * 16 + i * 8192, R, C); voffA[i] = (unsigned)(R * K + C) * 2u; voffB[i] = voffA[i]; }
    const size_t kstep = (size_t)(BK * 2);
    const size_t hstep = (size_t)HALF * K * 2;
    const size_t tstep = 2 * hstep;
    const unsigned ldsw = (unsigned)wid * 1024u;
    const int aoff = lds_byte(wr * 64 + fr, fq * 8), boff = lds_byte(wc * 32 + fr, fq * 8);
#define PG8_SA(b, h) (((b) * 2 + (h)) * HTB)
#define PG8_SB(b, h) ((4 + (b) * 2 + (h)) * HTB)
#define PG8_STAGE(bufoff, gbase, voff) do { _Pragma("unroll") for (int _i = 0; _i < 2; ++_i) \
        __builtin_amdgcn_global_load_lds((const unsigned*)((const char*)(gbase) + (voff)[_i]), (PG8_LAS unsigned*)(lds + (bufoff) + ldsw + _i * 8192), 16, 0, 0); } while (0)
#define PG8_LDA(dst, b, h) do { _Pragma("unroll") for (int m = 0; m < 4; ++m) _Pragma("unroll") for (int k = 0; k < 2; ++k) dst[m][k] = *(const PG8_LAS bf16x8*)(lds + PG8_SA(b, h) + aoff + m * 2048 + k * 1024); } while (0)
#define PG8_LDB(dst, b, h) do { _Pragma("unroll") for (int n = 0; n < 2; ++n) _Pragma("unroll") for (int k = 0; k < 2; ++k) dst[n][k] = *(const PG8_LAS bf16x8*)(lds + PG8_SB(b, h) + boff + n * 2048 + k * 1024); } while (0)
#define PG8_MMA(ai, bj, At, Bt) do { __builtin_amdgcn_s_setprio(1); _Pragma("unroll") for (int m = 0; m < 4; ++m) _Pragma("unroll") for (int n = 0; n < 2; ++n) _Pragma("unroll") for (int k = 0; k < 2; ++k) \
        acc[ai][bj][m][n] = __builtin_amdgcn_mfma_f32_16x16x32_bf16(Bt[n][k], At[m][k], acc[ai][bj][m][n], 0, 0, 0); __builtin_amdgcn_s_setprio(0); } while (0)
#define PG8_WAIT_V(n) asm volatile("s_waitcnt vmcnt(" #n ")" ::: "memory")
#define PG8_WAIT_L(n) asm volatile("s_waitcnt lgkmcnt(" #n ")" ::: "memory")
#define PG8_BAR __builtin_amdgcn_s_barrier()
#define PG8_SCHED __builtin_amdgcn_sched_barrier(0)
    Unit cur, nxt; int ui = 0;
    if (!S.next(0, cur)) return;
    f32x4 acc[2][2][4][2];
#pragma unroll
    for (int a = 0; a < 2; ++a)
#pragma unroll
        for (int b = 0; b < 2; ++b)
#pragma unroll
            for (int m = 0; m < 4; ++m)
#pragma unroll
                for (int n = 0; n < 2; ++n) acc[a][b][m][n] = (f32x4){0.f, 0.f, 0.f, 0.f};
    bf16x8 At[4][2], B0[2][2], B1[2][2];
    const char* cA = (const char*)g.A + (size_t)cur.pm * tstep; const char* cB = (const char*)g.Bt + (size_t)cur.pn * tstep;
    PG8_STAGE(PG8_SB(0, 0), cB, voffB); PG8_STAGE(PG8_SB(0, 1), cB + hstep, voffB); PG8_STAGE(PG8_SA(0, 0), cA, voffA); PG8_STAGE(PG8_SA(0, 1), cA + hstep, voffA);
    if (wr == 1) PG8_BAR;
    PG8_WAIT_V(2); PG8_BAR;
    PG8_STAGE(PG8_SB(1, 0), cB + kstep, voffB); PG8_STAGE(PG8_SA(1, 0), cA + kstep, voffA); PG8_STAGE(PG8_SB(1, 1), cB + hstep + kstep, voffB);
    PG8_WAIT_V(6); PG8_BAR;
    for (;;) {
        const bool has_next = S.next(ui + 1, nxt);
        const char* nA = has_next ? (const char*)g.A + (size_t)nxt.pm * tstep : cA; const char* nB = has_next ? (const char*)g.Bt + (size_t)nxt.pn * tstep : cB;
        for (int t = 0; t < nt; t += 2) {
            const bool last = (t == nt - 2);
            const char* a1 = cA + (size_t)(t + 1) * kstep;
            const char* a2 = last ? nA : cA + (size_t)(t + 2) * kstep; const char* b2 = last ? nB : cB + (size_t)(t + 2) * kstep;
            const char* a3 = a2 + kstep; const char* b3 = b2 + kstep;
            PG8_LDB(B0, 0, 0); PG8_LDB(B1, 0, 1); PG8_SCHED; PG8_LDA(At, 0, 0); PG8_STAGE(PG8_SA(1, 1), a1 + hstep, voffA);
            PG8_WAIT_V(8); PG8_WAIT_L(0); PG8_BAR; PG8_MMA(0, 0, At, B0); PG8_MMA(0, 1, At, B1); PG8_BAR; PG8_SCHED;
            PG8_LDA(At, 0, 1); PG8_STAGE(PG8_SB(0, 0), b2, voffB); PG8_STAGE(PG8_SB(0, 1), b2 + hstep, voffB); PG8_STAGE(PG8_SA(0, 0), a2, voffA);
            PG8_WAIT_V(8); PG8_WAIT_L(0); PG8_BAR; PG8_MMA(1, 0, At, B0); PG8_MMA(1, 1, At, B1); PG8_BAR; PG8_SCHED;
            PG8_LDB(B0, 1, 0); PG8_LDB(B1, 1, 1); PG8_SCHED; PG8_LDA(At, 1, 0); PG8_STAGE(PG8_SA(0, 1), a2 + hstep, voffA);
            PG8_WAIT_V(8); PG8_WAIT_L(0); PG8_BAR; PG8_MMA(0, 0, At, B0); PG8_MMA(0, 1, At, B1); PG8_BAR; PG8_SCHED;
            PG8_LDA(At, 1, 1); PG8_STAGE(PG8_SB(1, 0), b3, voffB); PG8_STAGE(PG8_SB(1, 1), b3 + hstep, voffB); PG8_STAGE(PG8_SA(1, 0), a3, voffA);
            PG8_WAIT_V(8); PG8_WAIT_L(0); PG8_BAR; PG8_MMA(1, 0, At, B0); PG8_MMA(1, 1, At, B1); PG8_BAR; PG8_SCHED;
        }
        if (wr == 0) PG8_BAR;
        E(acc, cur, wr, wc, fr, fq);
        if (!has_next) break;
#pragma unroll
        for (int a = 0; a < 2; ++a)
#pragma unroll
            for (int b = 0; b < 2; ++b)
#pragma unroll
                for (int m = 0; m < 4; ++m)
#pragma unroll
                    for (int n = 0; n < 2; ++n) acc[a][b][m][n] = (f32x4){0.f, 0.f, 0.f, 0.f};
        cur = nxt; cA = nA; cB = nB; ++ui;
        if (wr == 1) PG8_BAR;
    }
    PG8_WAIT_V(0);
    PG8_BAR;
#undef PG8_SA
#undef PG8_SB
#undef PG8_STAGE
#undef PG8_LDA
#undef PG8_LDB
#undef PG8_MMA
#undef PG8_WAIT_V
#undef PG8_WAIT_L
#undef PG8_BAR
#undef PG8_SCHED
}
}

struct EpiQKV {
    int even;
    bf16_t* Q; bf16_t* Kb; bf16_t* Vt; bf16_t* U;
    const float* qg; const float* kg; const LAS float* rope; unsigned* maxw;
    DI void operator()(const f32x4 (&acc)[2][2][4][2], const pg8::Unit& u, int wr, int wc, int fr, int fq) const {
        int kind, head;
        const int pn = u.pn;
        if (even) { if (pn < 2) { kind = 0; head = pn * 4 + wc; } else if (pn == 2) { if (wc < 2) { kind = 1; head = wc; } else { kind = 2; head = wc - 2; } } else { kind = 3; head = (pn - 3) * 4 + wc; } }
        else { if (pn < 4) { kind = 0; head = pn * 4 + wc; } else if (pn == 4) { kind = 1; head = wc; } else { kind = 2; head = wc; } }
        const int qw = even ? 512 : 1024, kvw = even ? 128 : 256, nkv = even ? 2 : 4;
        const int gq = u.pm / GPAN, pl = u.pm - gq * GPAN;
        const bool lat = pl < 128;
        int b, pos0;
        if (lat) { b = 16 * gq + (pl >> 3); pos0 = (pl & 7) * 256; } else { b = 16 * gq + (pl - 128); pos0 = SEQ; }
        const int half = fq >> 1, f0 = 8 * (fq & 1);
        const int dbase = 32 * half + f0;
        f32x4 gn[2][2];
        const bool donorm = even && kind <= 1;
        if (donorm) { const float* gp = (kind == 0) ? qg : kg;
#pragma unroll
            for (int bj = 0; bj < 2; ++bj)
#pragma unroll
                for (int n = 0; n < 2; ++n) gn[bj][n] = *(const f32x4*)(gp + dbase + 16 * bj + 4 * n); }
        const float qs = (kind == 0) ? C2 : 1.0f;
        float rmaxn = 0.f;
#pragma unroll
        for (int ai = 0; ai < 2; ++ai)
#pragma unroll
            for (int m = 0; m < 4; ++m) {
                const int rl = 128 * ai + 64 * wr + 16 * m + fr;
                const size_t grow = (size_t)u.pm * 256 + rl;
                const int pos = pos0 + rl;
                f32x4 v[2][2];
#pragma unroll
                for (int bj = 0; bj < 2; ++bj)
#pragma unroll
                    for (int n = 0; n < 2; ++n) v[bj][n] = acc[ai][bj][m][n];
                if (kind <= 1) {
                    if (donorm) {
                        float ss = 0.f;
#pragma unroll
                        for (int bj = 0; bj < 2; ++bj)
#pragma unroll
                            for (int n = 0; n < 2; ++n) ss += (v[bj][n][0] * v[bj][n][0] + v[bj][n][1] * v[bj][n][1]) + (v[bj][n][2] * v[bj][n][2] + v[bj][n][3] * v[bj][n][3]);
                        ss += __shfl_xor(ss, 16); ss += __shfl_xor(ss, 32);
                        const float rstd = rsqrtf(ss * (1.0f / 64.0f) + EPS);
#pragma unroll
                        for (int bj = 0; bj < 2; ++bj)
#pragma unroll
                            for (int n = 0; n < 2; ++n) v[bj][n] = v[bj][n] * rstd * gn[bj][n];
                    }
                    if (lat) {
                        const int p = half ? (pos & 63) : (pos >> 6);
                        const LAS f32x4* rp = (const LAS f32x4*)(rope + (p * 16 + f0) * 2);
#pragma unroll
                        for (int n = 0; n < 2; ++n) {
                            const f32x4 cs0 = rp[2 * n], cs1 = rp[2 * n + 1];
                            const float c[4] = {cs0[0], cs0[2], cs1[0], cs1[2]}, s[4] = {cs0[1], cs0[3], cs1[1], cs1[3]};
#pragma unroll
                            for (int i = 0; i < 4; ++i) { const float a1 = v[0][n][i], a2 = v[1][n][i]; v[0][n][i] = a1 * c[i] - a2 * s[i]; v[1][n][i] = a2 * c[i] + a1 * s[i]; }
                        }
                    }
                    if (maxw) { float nn = 0.f;
#pragma unroll
                        for (int bj = 0; bj < 2; ++bj)
#pragma unroll
                            for (int n = 0; n < 2; ++n) nn += (v[bj][n][0] * v[bj][n][0] + v[bj][n][1] * v[bj][n][1]) + (v[bj][n][2] * v[bj][n][2] + v[bj][n][3] * v[bj][n][3]);
                        nn += __shfl_xor(nn, 16); nn += __shfl_xor(nn, 32); rmaxn = fmaxf(rmaxn, nn * qs * qs); }
                    bf16_t* dst = (kind == 0) ? (Q + grow * qw + head * 64) : (Kb + ((size_t)b * KVR + pos) * kvw + head * 64);
#pragma unroll
                    for (int bj = 0; bj < 2; ++bj) {
                        u32x4 w; w.x = cvtpk(v[bj][0][0] * qs, v[bj][0][1] * qs); w.y = cvtpk(v[bj][0][2] * qs, v[bj][0][3] * qs);
                        w.z = cvtpk(v[bj][1][0] * qs, v[bj][1][1] * qs); w.w = cvtpk(v[bj][1][2] * qs, v[bj][1][3] * qs);
                        *(u32x4*)(dst + dbase + 16 * bj) = w;
                    }
                } else if (kind == 2) {
                    const int posp = (pos & ~15) | (pos & 3) | ((pos & 4) << 1) | ((pos & 8) >> 1);
                    bf16_t* dst = Vt + ((size_t)(b * nkv + head) * 64) * KVR + posp;
#pragma unroll
                    for (int bj = 0; bj < 2; ++bj)
#pragma unroll
                        for (int n = 0; n < 2; ++n)
#pragma unroll
                            for (int i = 0; i < 4; ++i) { const int d = dbase + 16 * bj + 4 * n + i; dst[(size_t)d * KVR] = (bf16_t)(cvtpk(v[bj][n][i], 0.f) & 0xffffu); }
                } else {
                    bf16_t* dst = U + grow * 512 + head * 64;
#pragma unroll
                    for (int bj = 0; bj < 2; ++bj) {
                        u32x4 w; w.x = cvtpk(v[bj][0][0], v[bj][0][1]); w.y = cvtpk(v[bj][0][2], v[bj][0][3]);
                        w.z = cvtpk(v[bj][1][0], v[bj][1][1]); w.w = cvtpk(v[bj][1][2], v[bj][1][3]);
                        *(u32x4*)(dst + dbase + 16 * bj) = w;
                    }
                }
            }
        if (maxw && kind <= 1) {
            rmaxn = fmaxf(rmaxn, __shfl_xor(rmaxn, 1)); rmaxn = fmaxf(rmaxn, __shfl_xor(rmaxn, 2)); rmaxn = fmaxf(rmaxn, __shfl_xor(rmaxn, 4)); rmaxn = fmaxf(rmaxn, __shfl_xor(rmaxn, 8));
            if (fr == 0 && fq == 0) __hip_atomic_fetch_max(maxw + b * 20 + (kind == 0 ? head : 16 + head), __float_as_uint(rmaxn), __ATOMIC_RELAXED, __HIP_MEMORY_SCOPE_AGENT);
        }
    }
};

struct EpiY {
    bf16_t* Y; float* PART;
    DI void operator()(const f32x4 (&acc)[2][2][4][2], const pg8::Unit& u, int wr, int wc, int fr, int fq) const {
#pragma unroll
        for (int ai = 0; ai < 2; ++ai)
#pragma unroll
            for (int m = 0; m < 4; ++m) {
                const size_t row = (size_t)u.pm * 256 + 128 * ai + 64 * wr + 16 * m + fr;
                float ss = 0.f;
#pragma unroll
                for (int bj = 0; bj < 2; ++bj) {
                    const f32x4 v0 = acc[ai][bj][m][0], v1 = acc[ai][bj][m][1];
                    ss += (v0[0] * v0[0] + v0[1] * v0[1]) + (v0[2] * v0[2] + v0[3] * v0[3]) + (v1[0] * v1[0] + v1[1] * v1[1]) + (v1[2] * v1[2] + v1[3] * v1[3]);
                    u32x4 w; w.x = cvtpk(v0[0], v0[1]); w.y = cvtpk(v0[2], v0[3]); w.z = cvtpk(v1[0], v1[1]); w.w = cvtpk(v1[2], v1[3]);
                    *(u32x4*)(Y + row * 1024 + u.pn * 256 + 128 * bj + 32 * wc + 8 * fq) = w;
                }
                ss += __shfl_xor(ss, 16); ss += __shfl_xor(ss, 32);
                if (fq == 0) PART[row * 16 + u.pn * 4 + wc] = ss;
            }
    }
};

struct EpiSwiGLU {
    bf16_t* ACT;
    DI void operator()(const f32x4 (&acc)[2][2][4][2], const pg8::Unit& u, int wr, int wc, int fr, int fq) const {
#pragma unroll
        for (int ai = 0; ai < 2; ++ai)
#pragma unroll
            for (int m = 0; m < 4; ++m) {
                const size_t row = (size_t)u.pm * 256 + 128 * ai + 64 * wr + 16 * m + fr;
                float o[2][4];
#pragma unroll
                for (int n = 0; n < 2; ++n)
#pragma unroll
                    for (int i = 0; i < 4; ++i) { const float gt = acc[ai][0][m][n][i], up = acc[ai][1][m][n][i]; o[n][i] = gt * up * __builtin_amdgcn_rcpf(1.0f + __builtin_amdgcn_exp2f(-LOG2E * gt)); }
                u32x4 w; w.x = cvtpk(o[0][0], o[0][1]); w.y = cvtpk(o[0][2], o[0][3]); w.z = cvtpk(o[1][0], o[1][1]); w.w = cvtpk(o[1][2], o[1][3]);
                *(u32x4*)(ACT + row * FFN + u.pn * 128 + 32 * wc + 8 * fq) = w;
            }
    }
};

DI int newrow(int type, int o) {
    if (type == 0) { const int ol = o & 255, bj = ol >> 7, wc = (ol >> 5) & 3, fq = (ol >> 3) & 3, n = (ol >> 2) & 1, i = ol & 3; return (o & ~255) + 128 * bj + 32 * wc + 16 * n + 4 * fq + i; }
    if (type == 1) { const int ol = o & 255, wc = ol >> 6, d = ol & 63, fq = 2 * (d >> 5) + ((d >> 3) & 1), bj = (d >> 4) & 1, n = (d >> 2) & 1, i = d & 3; return (o & ~255) + 128 * bj + 32 * wc + 16 * n + 4 * fq + i; }
    if (type == 2) { const int isu = o >= FFN ? 1 : 0, j = o - FFN * isu, pn = j >> 7, jj = j & 127, wc = jj >> 5, fq = (jj >> 3) & 3, n = (jj >> 2) & 1, i = jj & 3; return pn * 256 + 128 * isu + 32 * wc + 16 * n + 4 * fq + i; }
    return o;
}
DI void prep_item(const float* W, int K, int N, bf16_t* WT, int type, int item, LAS float* scr) {
    int tid_ = threadIdx.x; asm volatile("" : "+v"(tid_)); const int tid = tid_;
    const int nblk = N / 64, kb = item / nblk, nb = item % nblk, k0 = 64 * kb, n0 = 64 * nb;
    { const int r = tid >> 4, c4 = (tid & 15) * 4;
#pragma unroll
      for (int p = 0; p < 2; ++p) { const int kk = r + 32 * p; const f32x4 v = *(const f32x4*)(W + (size_t)(k0 + kk) * N + n0 + c4);
          scr[kk * 65 + c4 + 0] = v[0]; scr[kk * 65 + c4 + 1] = v[1]; scr[kk * 65 + c4 + 2] = v[2]; scr[kk * 65 + c4 + 3] = v[3]; } }
    __syncthreads();
    { const int n = tid >> 3, kc = (tid & 7) * 8; const LAS float* s = scr + kc * 65 + n;
      u32x4 o; o.x = cvtpk(s[0 * 65], s[1 * 65]); o.y = cvtpk(s[2 * 65], s[3 * 65]); o.z = cvtpk(s[4 * 65], s[5 * 65]); o.w = cvtpk(s[6 * 65], s[7 * 65]);
      *(u32x4*)(WT + (size_t)newrow(type, n0 + n) * K + k0 + kc) = o; }
    __syncthreads();
}

DI void prep_layer(int l, int worker, int nworkers, unsigned char* ws, LAS unsigned char* lds, const float* we_in, const float* we_out, const float* we_pool,
                   const float* wo_in, const float* wo_out, const float* w_f1, const float* w_f2) {
    constexpr int I_IN = 384, I_OUT = 256, I_POOL = 16, I_F1 = 1408, I_F2 = 704, I_LAYER = I_IN + I_OUT + I_POOL + I_F1 + I_F2;
    const int li = l >> 1; const bool ev = (l & 1) == 0;
    unsigned char* wl = ws + WS_W + (size_t)l * WL_STRIDE;
    LAS float* scr = (LAS float*)lds;
    for (int it = worker; it < I_LAYER; it += nworkers) {
        int r = it;
        if (r < I_IN) { if (ev) { if (r < 320) prep_item(we_in + (size_t)li * 1024 * 1280, 1024, 1280, (bf16_t*)(wl + WL_IN), 1, r, scr); }
                        else prep_item(wo_in + (size_t)li * 1024 * 1536, 1024, 1536, (bf16_t*)(wl + WL_IN), 1, r, scr); continue; } r -= I_IN;
        if (r < I_OUT) { prep_item((ev ? we_out : wo_out) + (size_t)li * 1024 * 1024, 1024, 1024, (bf16_t*)(wl + WL_OUT), 0, r, scr); continue; } r -= I_OUT;
        if (r < I_POOL) { if (ev) { const int gq = r >> 2; prep_item(we_pool + ((size_t)li * 4 + gq) * 128 * 128, 128, 128, (bf16_t*)(wl + WL_POOL) + (size_t)gq * 128 * 128, 3, r & 3, scr); } continue; } r -= I_POOL;
        if (r < I_F1) { prep_item(w_f1 + (size_t)l * 1024 * 5632, 1024, 5632, (bf16_t*)(wl + WL_F1), 2, r, scr); continue; } r -= I_F1;
        prep_item(w_f2 + (size_t)l * FFN * 1024, FFN, 1024, (bf16_t*)(wl + WL_F2), 0, r, scr);
    }
}

DI void mod_item(int item, const float* c, const float* cctx, const float* w_mod, const float* b_mod, float* MOD, LAS unsigned char* lds) {
    const int tid = threadIdx.x;
    const int l = item / 48, n0 = (item % 48) * 128;
    LAS float* S = (LAS float*)lds;
    for (int idx = tid; idx < 33 * 1024; idx += 512) { const int b = idx >> 10, k = idx & 1023; const float cv = (b < 32) ? c[b * 1024 + k] : cctx[k]; S[idx] = cv / (1.0f + __expf(-cv)); }
    __syncthreads();
    const int lane = tid & 63, kq = tid >> 6;
    float acc0[33], acc1[33];
#pragma unroll
    for (int b = 0; b < 33; ++b) { acc0[b] = 0.f; acc1[b] = 0.f; }
    const float* W = w_mod + (size_t)l * 1024 * 6144 + n0 + lane;
#pragma unroll 2
    for (int k = kq * 128; k < kq * 128 + 128; k += 4) {
        float wa[4], wb[4];
#pragma unroll
        for (int i = 0; i < 4; ++i) { wa[i] = __builtin_nontemporal_load(W + (size_t)(k + i) * 6144); wb[i] = __builtin_nontemporal_load(W + (size_t)(k + i) * 6144 + 64); }
#pragma unroll
        for (int b = 0; b < 33; ++b) { const f32x4 sv = *(const LAS f32x4*)(S + b * 1024 + k);
            acc0[b] += (sv[0] * wa[0] + sv[1] * wa[1]) + (sv[2] * wa[2] + sv[3] * wa[3]);
            acc1[b] += (sv[0] * wb[0] + sv[1] * wb[1]) + (sv[2] * wb[2] + sv[3] * wb[3]); }
    }
    __syncthreads();
    LAS float* red = (LAS float*)lds;
#pragma unroll
    for (int b = 0; b < 33; ++b) { red[(kq * 33 + b) * 128 + lane] = acc0[b]; red[(kq * 33 + b) * 128 + 64 + lane] = acc1[b]; }
    __syncthreads();
    for (int idx = tid; idx < 33 * 128; idx += 512) { const int b = idx >> 7, cc = idx & 127;
        float v = 0.f;
#pragma unroll
        for (int q = 0; q < 8; ++q) v += red[(q * 33 + b) * 128 + cc];
        MOD[((size_t)l * 33 + b) * 6144 + n0 + cc] = v + b_mod[l * 6144 + n0 + cc]; }
    __syncthreads();
}

DI void rope_table(LAS float* rope) {
    for (int idx = threadIdx.x; idx < 1024; idx += 512) {
        const int pos = idx >> 4, f = idx & 15;
        double fr = 1.0; const double q = 0.56234132519034908;
        for (int i = 0; i < f; ++i) fr *= q;
        const float ang = (float)pos * (float)fr;
        double r = (double)ang; const double twopi = 6.283185307179586476925;
        const double kk = __builtin_rint(r * (1.0 / twopi)); r -= kk * twopi;
        const double r2 = r * r; double s = r, ts = r, cc = 1.0, tc = 1.0;
#pragma unroll
        for (int n = 1; n <= 14; ++n) { ts *= r2 * (-1.0 / (double)((2 * n) * (2 * n + 1))); s += ts; tc *= r2 * (-1.0 / (double)((2 * n - 1) * (2 * n))); cc += tc; }
        rope[idx * 2] = (float)cc; rope[idx * 2 + 1] = (float)s;
    }
}

DI float wave_sum(float v) {
#pragma unroll
    for (int o = 1; o < 64; o <<= 1) v += __shfl_xor(v, o);
    return v;
}
struct RowArgs {
    const float* xinL; const float* xinC; float* xoutL; float* xoutC;
    const bf16_t* Y; const float* PART; const float* gate; const float* gpost;
    const bf16_t* Y2; const float* PART2; const float* gate2; const float* gpost2;
    bf16_t* H; const float* gpre; const float* sh; const float* sc;
    int M; int upd; int upd2; int wr; int nxt; int xin16; int xout16;
};
template <int NR>
DI void row_work(const RowArgs& a, int row0, int lane) {
    const int gq = row0 / GROWS, rl0 = row0 - gq * GROWS; const bool lat = rl0 < GLAT;
    const int bb = lat ? (16 * gq + (rl0 >> 11)) : 32;
    const size_t xrow0 = lat ? (size_t)(gq * GLAT + rl0) : (size_t)(gq * 4096 + rl0 - GLAT);
    const float* xi0 = (lat ? a.xinL : a.xinC) + xrow0 * 1024;
    f32x4 x[NR][4];
    if (a.xin16) {
#pragma unroll
        for (int r = 0; r < NR; ++r)
#pragma unroll
            for (int j = 0; j < 4; ++j) { const u32x2 xb = __builtin_nontemporal_load((const u32x2*)((const bf16_t*)(xi0 + (size_t)r * 1024) + 4 * lane + 256 * j));
                x[r][j] = (f32x4){bflo(xb.x), bfhi(xb.x), bflo(xb.y), bfhi(xb.y)}; }
    } else {
#pragma unroll
        for (int r = 0; r < NR; ++r)
#pragma unroll
            for (int j = 0; j < 4; ++j) x[r][j] = __builtin_nontemporal_load((const f32x4*)(xi0 + (size_t)r * 1024 + 4 * lane + 256 * j));
    }
#pragma unroll
    for (int br = 0; br < 2; ++br) {
        if (br == 0 ? !a.upd : !a.upd2) continue;
        const bf16_t* Yp = (br == 0 ? a.Y : a.Y2) + (size_t)row0 * 1024 + 4 * lane; const float* Pp = (br == 0 ? a.PART : a.PART2) + (size_t)row0 * 16 + (lane & 15);
        const float* gatep = (br == 0 ? a.gate : a.gate2) + (size_t)bb * 6144 + 4 * lane; const float* gpostp = (br == 0 ? a.gpost : a.gpost2) + 4 * lane;
        u32x2 yb[NR][4]; float ps[NR];
#pragma unroll
        for (int r = 0; r < NR; ++r) {
#pragma unroll
            for (int j = 0; j < 4; ++j) yb[r][j] = __builtin_nontemporal_load((const u32x2*)(Yp + (size_t)r * 1024 + 256 * j));
            ps[r] = Pp[r * 16];
        }
        float rstd[NR];
#pragma unroll
        for (int r = 0; r < NR; ++r) {
            float ss = ps[r]; ss += __shfl_xor(ss, 1); ss += __shfl_xor(ss, 2); ss += __shfl_xor(ss, 4); ss += __shfl_xor(ss, 8);
            rstd[r] = rsqrtf(ss * (1.0f / 1024.0f) + EPS);
        }
#pragma unroll
        for (int j = 0; j < 4; ++j) {
            const f32x4 gsc = *(const f32x4*)(gpostp + 256 * j) * *(const f32x4*)(gatep + 256 * j);
#pragma unroll
            for (int r = 0; r < NR; ++r) {
                const f32x4 y = {bflo(yb[r][j].x), bfhi(yb[r][j].x), bflo(yb[r][j].y), bfhi(yb[r][j].y)};
                x[r][j] = x[r][j] + gsc * (y * rstd[r]);
            }
        }
    }
    if (a.wr) {
        float* xo0 = (lat ? a.xoutL : a.xoutC) + xrow0 * 1024;
        if (a.xout16) {
#pragma unroll
            for (int r = 0; r < NR; ++r)
#pragma unroll
                for (int j = 0; j < 4; ++j) { u32x2 w; w.x = cvtpk(x[r][j][0], x[r][j][1]); w.y = cvtpk(x[r][j][2], x[r][j][3]);
                    __builtin_nontemporal_store(w, (u32x2*)((bf16_t*)(xo0 + (size_t)r * 1024) + 4 * lane + 256 * j)); }
        } else {
#pragma unroll
            for (int r = 0; r < NR; ++r)
#pragma unroll
                for (int j = 0; j < 4; ++j) __builtin_nontemporal_store(x[r][j], (f32x4*)(xo0 + (size_t)r * 1024 + 4 * lane + 256 * j));
        }
    }
    if (a.nxt) {
        float rstd2[NR];
#pragma unroll
        for (int r = 0; r < NR; ++r) {
            float s2 = 0.f;
#pragma unroll
            for (int j = 0; j < 4; ++j) s2 += (x[r][j][0] * x[r][j][0] + x[r][j][1] * x[r][j][1]) + (x[r][j][2] * x[r][j][2] + x[r][j][3] * x[r][j][3]);
            s2 = wave_sum(s2);
            rstd2[r] = rsqrtf(s2 * (1.0f / 1024.0f) + EPS);
        }
        const float* shp = a.sh + (size_t)bb * 6144 + 4 * lane; const float* scp = a.sc + (size_t)bb * 6144 + 4 * lane; const float* gp = a.gpre + 4 * lane;
        bf16_t* hp = a.H + (size_t)row0 * 1024 + 4 * lane;
#pragma unroll
        for (int j = 0; j < 4; ++j) {
            const f32x4 gm = *(const f32x4*)(gp + 256 * j) * (*(const f32x4*)(scp + 256 * j) + 1.0f), sv = *(const f32x4*)(shp + 256 * j);
#pragma unroll
            for (int r = 0; r < NR; ++r) {
                const f32x4 h = (x[r][j] * rstd2[r]) * gm + sv;
                u32x2 w; w.x = cvtpk(h[0], h[1]); w.y = cvtpk(h[2], h[3]);
                *(u32x2*)(hp + (size_t)r * 1024 + 256 * j) = w;
            }
        }
    }
}
DI void row_phase(const RowArgs& a, int gw, int ngw, int g) {
    int lane = threadIdx.x & 63; asm volatile("" : "+v"(lane));
    for (int rl = gw * 4; rl < a.M; rl += ngw * 4) {
        const int row = g * GROWS + rl;
        row_work<4>(a, row, lane);
    }
}

constexpr int AT_KB = 64 * 144, AT_VB = 64 * 144;
#define MFMA32(a, b, c) __builtin_amdgcn_mfma_f32_32x32x16_bf16((a), (b), (c), 0, 0, 0)
DI float fadd_s(float a, float b) { float r; asm("v_add_f32_e32 %0, %1, %2" : "=v"(r) : "v"(a), "v"(b)); return r; }
DI float swap_max(float m) { auto rr = __builtin_amdgcn_permlane32_swap(__float_as_uint(m), __float_as_uint(m), false, false); return fmaxf(__uint_as_float(rr[0]), __uint_as_float(rr[1])); }
DI float swap_sum(float m) { auto rr = __builtin_amdgcn_permlane32_swap(__float_as_uint(m), __float_as_uint(m), false, false); return __uint_as_float(rr[0]) + __uint_as_float(rr[1]); }
template <bool WINDOW, bool SINK, bool FIXED = false>
DI void attn_unit(LAS unsigned char* lds, const bf16_t* Qp, int qw, const bf16_t* Kb, int kvw, const bf16_t* Vb, bf16_t* Op,
                  int a_lo, int na, int qpos0, float sink2, float ref = 0.f) {
    int tid_ = threadIdx.x; asm volatile("" : "+v"(tid_));
    const int tid = tid_, lane = tid & 63, r32 = lane & 31, hi = lane >> 5; const int wid = __builtin_amdgcn_readfirstlane(tid >> 6);
    bf16x8 qf[4];
    { const bf16_t* qr = Qp + (size_t)(wid * 32 + r32) * qw + 8 * hi;
#pragma unroll
      for (int s = 0; s < 4; ++s) qf[s] = *(const bf16x8*)(qr + 16 * s); }
    constexpr float THR = 8.0f;
    float mhat = FIXED ? ref : (SINK ? sink2 : 0.f);
    float lrun = (SINK && hi == 0) ? (FIXED ? __builtin_amdgcn_exp2f(sink2 - ref) : 1.f) : 0.f;
    f32x16 o0, o1, negm;
#pragma unroll
    for (int i = 0; i < 16; ++i) { o0[i] = 0.f; o1[i] = 0.f; negm[i] = -mhat; }
    const int srow = tid >> 3, sch = tid & 7;
    const int ntiles = na + 4;
    const int qw0 = qpos0 + wid * 32;
    const int qpos = qw0 + r32;
#define AT_KEY(tt) ((((tt) < na) ? (a_lo + (tt)) : (32 + (tt) - na)) * 64)
#define AT_SKIP(tt) (WINDOW && (tt) < na && (((a_lo + (tt)) * 64 + 63 < qw0 - 128) || ((a_lo + (tt)) * 64 > qw0 + 159)))
#define AT_LDK(key0) (*(const u32x4*)(Kb + (size_t)((key0) + srow) * kvw + sch * 8))
#define AT_LDV(key0) (*(const u32x4*)(Vb + (size_t)srow * KVR + (key0) + sch * 8))
#define AT_STK(buf, reg) (*(LAS u32x4*)(lds + (buf) * AT_KB + srow * 144 + sch * 16) = (reg))
#define AT_STV(buf, reg) (*(LAS u32x4*)(lds + 2 * AT_KB + (buf) * AT_VB + srow * 144 + sch * 16) = (reg))
#define AT_KRD(KL) do { _Pragma("unroll") for (int s_ = 0; s_ < 4; ++s_) { kf[2 * s_] = *(const LAS bf16x8*)((KL) + r32 * 144 + (16 * s_ + 8 * hi) * 2); \
        kf[2 * s_ + 1] = *(const LAS bf16x8*)((KL) + (32 + r32) * 144 + (16 * s_ + 8 * hi) * 2); } __builtin_amdgcn_sched_barrier(0); } while (0)
#define AT_QK(S0, S1, KL, s) do { \
        if ((s) == 0) { S0 = MFMA32(kf[0], qf[0], negm); S1 = MFMA32(kf[1], qf[0], negm); } else { S0 = MFMA32(kf[2 * (s)], qf[s], S0); S1 = MFMA32(kf[2 * (s) + 1], qf[s], S1); } } while (0)
#define AT_SUM(P, sq) do { lacc = fadd_s(fadd_s(fadd_s(fadd_s(lacc, P[8 * (sq) + 0]), P[8 * (sq) + 2]), P[8 * (sq) + 4]), P[8 * (sq) + 6]); lacc2 = fadd_s(fadd_s(fadd_s(fadd_s(lacc2, P[8 * (sq) + 1]), P[8 * (sq) + 3]), P[8 * (sq) + 5]), P[8 * (sq) + 7]); } while (0)
#define AT_VRD(VL) do { _Pragma("unroll") for (int ks_ = 0; ks_ < 4; ++ks_) { const int koff_ = (32 * (ks_ >> 1) + 16 * (ks_ & 1) + 8 * hi) * 2; \
        vf[2 * ks_] = *(const LAS bf16x8*)((VL) + r32 * 144 + koff_); vf[2 * ks_ + 1] = *(const LAS bf16x8*)((VL) + (32 + r32) * 144 + koff_); } __builtin_amdgcn_sched_barrier(0); } while (0)
#define AT_PV(VL, ks, P, sq) do { \
        u32x4 w_; w_.x = cvtpk(P[8 * (sq) + 0], P[8 * (sq) + 1]); w_.y = cvtpk(P[8 * (sq) + 2], P[8 * (sq) + 3]); w_.z = cvtpk(P[8 * (sq) + 4], P[8 * (sq) + 5]); w_.w = cvtpk(P[8 * (sq) + 6], P[8 * (sq) + 7]); \
        const bf16x8 pb_ = __builtin_bit_cast(bf16x8, w_); \
        o0 = MFMA32(vf[2 * (ks)], pb_, o0); o1 = MFMA32(vf[2 * (ks) + 1], pb_, o1); } while (0)
#define AT_EXP8(D, Sx, sq) do { _Pragma("unroll") for (int e_ = 0; e_ < 8; ++e_) D[8 * (sq) + e_] = __builtin_amdgcn_exp2f(Sx[8 * (sq) + e_]); } while (0)
#define AT_MASK(S0, S1, tt) do { \
        if (WINDOW && (tt) < na) { const int k0_ = (a_lo + (tt)) * 64; \
            if (!((k0_ >= qw0 + 31 - 128) && (k0_ + 63 <= qw0 + 128))) { const int x_ = qpos - k0_ - 4 * hi + 128; \
            _Pragma("unroll") for (int i = 0; i < 16; ++i) { const int c_ = (i & 3) + 8 * (i >> 2); \
                if ((unsigned)(x_ - c_) > 256u) S0[i] = -INFINITY; if ((unsigned)(x_ - c_ - 32) > 256u) S1[i] = -INFINITY; } } } } while (0)
#define AT_DECIDE(S0, S1, tt, FORCE) do { \
        if (WINDOW && (tt) < na) { const int k0_ = (a_lo + (tt)) * 64; \
            if (!((k0_ >= qw0 + 31 - 128) && (k0_ + 63 <= qw0 + 128))) { const int x_ = qpos - k0_ - 4 * hi + 128; \
            _Pragma("unroll") for (int i = 0; i < 16; ++i) { const int c_ = (i & 3) + 8 * (i >> 2); \
                if ((unsigned)(x_ - c_) > 256u) S0[i] = -INFINITY; if ((unsigned)(x_ - c_ - 32) > 256u) S1[i] = -INFINITY; } } } \
        float rm_ = fmaxf(S0[0], S1[0]); \
        _Pragma("unroll") for (int i = 1; i < 16; ++i) rm_ = fmaxf(fmaxf(rm_, S0[i]), S1[i]); \
        rm_ = swap_max(rm_); \
        const bool trig_ = (FORCE) || (rm_ > THR); \
        if (__builtin_amdgcn_ballot_w64(trig_) != 0ull) { \
            const float dl_ = (FORCE) ? rm_ : fmaxf(rm_, 0.f); mhat += dl_; \
            _Pragma("unroll") for (int i = 0; i < 16; ++i) { S0[i] -= dl_; S1[i] -= dl_; } \
            _Pragma("unroll") for (int i = 0; i < 16; ++i) negm[i] = -mhat; \
            fsave = __builtin_amdgcn_exp2f(-dl_); lrun *= fsave; resc = true; } } while (0)

    u32x4 kreg, vreg;
    kreg = AT_LDK(AT_KEY(0));
    AT_STK(0, kreg);
    kreg = AT_LDK(AT_KEY(1)); vreg = AT_LDV(AT_KEY(0));
    __syncthreads();
    f32x16 sn0, sn1, pc0, pc1;
    bf16x8 kf[8], vf[8];
    float fsave = 1.f; bool resc = false;
    bool have_cur = !AT_SKIP(0);
    if (have_cur) {
        const LAS unsigned char* Kl = lds;
        AT_KRD(Kl);
        AT_QK(sn0, sn1, Kl, 0); AT_QK(sn0, sn1, Kl, 1); AT_QK(sn0, sn1, Kl, 2); AT_QK(sn0, sn1, Kl, 3);
        if (!FIXED) { AT_DECIDE(sn0, sn1, 0, !SINK); } else { AT_MASK(sn0, sn1, 0); }
        AT_EXP8(pc0, sn0, 0); AT_EXP8(pc0, sn0, 1); AT_EXP8(pc1, sn1, 0); AT_EXP8(pc1, sn1, 1);
        if (resc) {
#pragma unroll
            for (int i = 0; i < 16; ++i) { o0[i] *= fsave; o1[i] *= fsave; }
            resc = false; }
    }
    AT_STK(1, kreg); AT_STV(0, vreg);
    __syncthreads();
#define AT_ITER(t, DD, KLD, VLD, KST, VST) do { \
        if (t + 2 + DD < ntiles) KLD = AT_LDK(AT_KEY(t + 2 + DD)); \
        if (t + 1 + DD < ntiles) VLD = AT_LDV(AT_KEY(t + 1 + DD)); \
        const bool have_next = (t + 1 < ntiles) && !AT_SKIP(t + 1); \
        const LAS unsigned char* Kl = lds + ((t + 1) & 1) * AT_KB; \
        const LAS unsigned char* Vl = lds + 2 * AT_KB + (t & 1) * AT_VB; \
        float lacc = 0.f, lacc2 = 0.f; \
        if (have_cur && have_next) { \
            AT_KRD(Kl); \
            AT_QK(sn0, sn1, Kl, 0); AT_SUM(pc0, 0); \
            AT_QK(sn0, sn1, Kl, 1); AT_SUM(pc0, 1); \
            AT_QK(sn0, sn1, Kl, 2); AT_SUM(pc1, 0); \
            AT_QK(sn0, sn1, Kl, 3); AT_SUM(pc1, 1); \
            lrun += lacc + lacc2; \
            __builtin_amdgcn_sched_barrier(0); \
            AT_VRD(Vl); \
            if (!FIXED) { AT_DECIDE(sn0, sn1, t + 1, false); } else { AT_MASK(sn0, sn1, t + 1); } \
            AT_PV(Vl, 0, pc0, 0); AT_EXP8(pc0, sn0, 0); \
            AT_PV(Vl, 1, pc0, 1); AT_EXP8(pc0, sn0, 1); \
            AT_PV(Vl, 2, pc1, 0); AT_EXP8(pc1, sn1, 0); \
            AT_PV(Vl, 3, pc1, 1); AT_EXP8(pc1, sn1, 1); \
        } else { \
            if (have_cur) { AT_SUM(pc0, 0); AT_SUM(pc0, 1); AT_SUM(pc1, 0); AT_SUM(pc1, 1); lrun += lacc + lacc2; } \
            if (have_next) { AT_KRD(Kl); AT_QK(sn0, sn1, Kl, 0); AT_QK(sn0, sn1, Kl, 1); AT_QK(sn0, sn1, Kl, 2); AT_QK(sn0, sn1, Kl, 3); if (!FIXED) { AT_DECIDE(sn0, sn1, t + 1, false); } else { AT_MASK(sn0, sn1, t + 1); } } \
            if (have_cur) { AT_VRD(Vl); AT_PV(Vl, 0, pc0, 0); AT_PV(Vl, 1, pc0, 1); AT_PV(Vl, 2, pc1, 0); AT_PV(Vl, 3, pc1, 1); } \
            if (have_next) { AT_EXP8(pc0, sn0, 0); AT_EXP8(pc0, sn0, 1); AT_EXP8(pc1, sn1, 0); AT_EXP8(pc1, sn1, 1); } \
        } \
        if (resc) { \
            _Pragma("unroll") \
            for (int i = 0; i < 16; ++i) { o0[i] *= fsave; o1[i] *= fsave; } \
            resc = false; } \
        if (t + 2 < ntiles) AT_STK(t & 1, KST); \
        if (t + 1 < ntiles) AT_STV((t + 1) & 1, VST); \
        __syncthreads(); \
        have_cur = have_next; \
    } while (0)
    if constexpr (!WINDOW) {
        u32x4 kreg2, vreg2;
        if (ntiles > 2) kreg2 = AT_LDK(AT_KEY(2));
        vreg2 = AT_LDV(AT_KEY(1));
        for (int t2 = 0; t2 < ntiles; t2 += 2) {
            { const int t = t2; AT_ITER(t, 1, kreg, vreg, kreg2, vreg2); }
            { const int t = t2 + 1; AT_ITER(t, 1, kreg2, vreg2, kreg, vreg); }
        }
    } else {
        for (int t = 0; t < ntiles; ++t) { AT_ITER(t, 0, kreg, vreg, kreg, vreg); }
    }
#undef AT_ITER
#undef AT_KEY
#undef AT_SKIP
#undef AT_LDK
#undef AT_LDV
#undef AT_STK
#undef AT_STV
#undef AT_QK
#undef AT_KRD
#undef AT_VRD
#undef AT_SUM
#undef AT_PV
#undef AT_EXP8
#undef AT_DECIDE
#undef AT_MASK
    const float lt = swap_sum(lrun);
    const float inv = 1.0f / lt;
    bf16_t* orow = Op + (size_t)(wid * 32 + r32) * 1024 + 4 * hi;
#pragma unroll
    for (int g = 0; g < 4; ++g) {
        u32x2 w0, w1;
        w0.x = cvtpk(o0[4 * g + 0] * inv, o0[4 * g + 1] * inv); w0.y = cvtpk(o0[4 * g + 2] * inv, o0[4 * g + 3] * inv);
        w1.x = cvtpk(o1[4 * g + 0] * inv, o1[4 * g + 1] * inv); w1.y = cvtpk(o1[4 * g + 2] * inv, o1[4 * g + 3] * inv);
        *(u32x2*)(orow + 8 * g) = w0; *(u32x2*)(orow + 32 + 8 * g) = w1;
    }
}

template <int GI>
DI void pool_unit_t(int rt, const bf16_t* U, const bf16_t* WpT, const float* pscale, bf16_t* MIX) {
    constexpr int g = GI, w = 2 << GI, hw = w >> 1;
    int tid_ = threadIdx.x; asm volatile("" : "+v"(tid_));
    const int tid = tid_, lane = tid & 63, fr = lane & 15, fq = lane >> 4; const int wid = __builtin_amdgcn_readfirstlane(tid >> 6);
    const int row = rt * 128 + wid * 16 + fr;
    const int rlq = row % GROWS;
    const bool lat = rlq < GLAT;
    const int t = lat ? (rlq & (SEQ - 1)) : ((rlq - GLAT) & (CTX - 1));
    const int S = lat ? SEQ : CTX;
    const int base = row - t;
    const int lo = (t - hw) < 0 ? 0 : (t - hw), hi = (t + hw) > S ? S : (t + hw);
    const float icnt = 1.0f / (float)(hi - lo);
    bf16x8 af[4];
#pragma unroll
    for (int ks = 0; ks < 4; ++ks) {
        const int c0 = g * 128 + 32 * ks + 8 * fq;
        u32x4 uv[w];
#pragma unroll
        for (int j = 0; j < w; ++j) {
            const int p = t - hw + j; const bool ok = (p >= 0 && p < S);
            uv[j] = *(const u32x4*)(U + (size_t)(base + (ok ? p : t)) * 512 + c0);
        }
        const u32x4 us = *(const u32x4*)(U + (size_t)row * 512 + c0);
        float sum[8];
#pragma unroll
        for (int e = 0; e < 8; ++e) sum[e] = 0.f;
#pragma unroll
        for (int j = 0; j < w; ++j) {
            const int p = t - hw + j; const float wt = (p >= 0 && p < S) ? 1.0f : 0.0f;
            sum[0] += wt * bflo(uv[j].x); sum[1] += wt * bfhi(uv[j].x); sum[2] += wt * bflo(uv[j].y); sum[3] += wt * bfhi(uv[j].y);
            sum[4] += wt * bflo(uv[j].z); sum[5] += wt * bfhi(uv[j].z); sum[6] += wt * bflo(uv[j].w); sum[7] += wt * bfhi(uv[j].w);
        }
        const float u0 = bflo(us.x), u1 = bfhi(us.x), u2 = bflo(us.y), u3 = bfhi(us.y), u4 = bflo(us.z), u5 = bfhi(us.z), u6 = bflo(us.w), u7 = bfhi(us.w);
        u32x4 d; d.x = cvtpk(sum[0] * icnt - u0, sum[1] * icnt - u1); d.y = cvtpk(sum[2] * icnt - u2, sum[3] * icnt - u3);
        d.z = cvtpk(sum[4] * icnt - u4, sum[5] * icnt - u5); d.w = cvtpk(sum[6] * icnt - u6, sum[7] * icnt - u7);
        af[ks] = __builtin_bit_cast(bf16x8, d);
    }
    const bf16_t* wp = WpT + (size_t)g * 128 * 128;
#pragma unroll
    for (int nt = 0; nt < 8; ++nt) {
        f32x4 acc = {0.f, 0.f, 0.f, 0.f};
#pragma unroll
        for (int ks = 0; ks < 4; ++ks) {
            const bf16x8 bfrag = *(const bf16x8*)(wp + (size_t)(16 * nt + fr) * 128 + 32 * ks + 8 * fq);
            acc = __builtin_amdgcn_mfma_f32_16x16x32_bf16(bfrag, af[ks], acc, 0, 0, 0);
        }
        const int n = g * 128 + 16 * nt + 4 * fq;
        const f32x4 ps = *(const f32x4*)(pscale + n);
        u32x2 w2; w2.x = cvtpk(acc[0] * ps[0], acc[1] * ps[1]); w2.y = cvtpk(acc[2] * ps[2], acc[3] * ps[3]);
        *(u32x2*)(MIX + (size_t)row * 1024 + 512 + n) = w2;
    }
}
DI void pool_unit(int rt, int g, const bf16_t* U, const bf16_t* WpT, const float* pscale, bf16_t* MIX) {
    if (g == 0) pool_unit_t<0>(rt, U, WpT, pscale, MIX);
    else if (g == 1) pool_unit_t<1>(rt, U, WpT, pscale, MIX);
    else if (g == 2) pool_unit_t<2>(rt, U, WpT, pscale, MIX);
    else pool_unit_t<3>(rt, U, WpT, pscale, MIX);
}

#define XB_TMO      128
#define XB_XCNT(j)  (256  + 64 * (j))
#define XB_XSUB(j)  (1280 + 64 * (j))
#define XB_XGEN(j)  (2304 + 64 * (j))
#define XB_TOP      3328
#define XB_TOPGEN   3392
#define XCD_BAR_WORDS 3456
#define XB_SPIN_CAP (1u << 18)
__device__ __forceinline__ unsigned xb_ld(unsigned* p)              { return __hip_atomic_load(p, __ATOMIC_RELAXED, __HIP_MEMORY_SCOPE_AGENT); }
__device__ __forceinline__ unsigned xb_add(unsigned* p, unsigned v) { return __hip_atomic_fetch_add(p, v, __ATOMIC_RELAXED, __HIP_MEMORY_SCOPE_AGENT); }
__device__ __forceinline__ unsigned xb_xcc_id() { return (unsigned)__builtin_amdgcn_s_getreg((3 << 11) | 20) & 0xFu; }
#define XB_SPIN(cond, bar) do { unsigned _sp = 0; while (cond) { __builtin_amdgcn_s_sleep(1); \
    if ((++_sp & 255u) == 0u) { if (xb_ld(&(bar)[XB_TMO])) break; if (_sp > XB_SPIN_CAP) { atomicAdd(&(bar)[XB_TMO], 1u); break; } } } } while (0)
struct XcdBarrier { unsigned* bar; unsigned x; volatile LAS unsigned* st; unsigned gsize; };
__device__ __forceinline__ XcdBarrier xcd_barrier_post(unsigned* bar, volatile LAS unsigned* st, unsigned gsize) {
    XcdBarrier b; b.bar = bar; b.x = xb_xcc_id(); b.st = st; b.gsize = gsize;
    if (threadIdx.x == 0) (void)xb_add(&bar[XB_XCNT(b.x)], 1u);
    return b;
}
__device__ __forceinline__ void xcd_barrier_complete(unsigned* bar, unsigned x, unsigned G, unsigned& nloc, unsigned& nx) {
    unsigned sum, cnt, mine, sp = 0u;
    for (;;) {
        sum = 0u; cnt = 0u; mine = 0u;
#pragma unroll
        for (unsigned j = 0; j < 16; ++j) { const unsigned c = xb_ld(&bar[XB_XCNT(j)]); sum += c; cnt += (c > 0u) ? 1u : 0u; mine = (j == x) ? c : mine; }
        if (sum == G) break;
        __builtin_amdgcn_s_sleep(1);
        if ((++sp & 255u) == 0u) { if (xb_ld(&bar[XB_TMO])) break; if (sp > XB_SPIN_CAP) { atomicAdd(&bar[XB_TMO], 1u); break; } }
    }
    nloc = mine > 0u ? mine : 1u; nx = cnt > 0u ? cnt : 1u;
}
__device__ __forceinline__ void xcd_barrier(const XcdBarrier& b) {
    asm volatile("s_waitcnt vmcnt(0)" ::: "memory");
    __syncthreads();
    if (threadIdx.x == 0) {
        unsigned* bar = b.bar; asm volatile("" : "+s"(bar));
        unsigned bx_ = b.x; asm volatile("" : "+s"(bx_));
        __builtin_amdgcn_s_waitcnt(0);
        unsigned nloc = b.st[0], nx = b.st[1];
        if (nloc == 0u) { xcd_barrier_complete(bar, bx_, b.gsize, nloc, nx); b.st[0] = nloc; b.st[1] = nx; }
        const unsigned old = xb_add(&bar[XB_XSUB(bx_)], 1u);
        const unsigned gen = old / nloc;
        if (old + 1u == (gen + 1u) * nloc) {
            __builtin_amdgcn_fence(__ATOMIC_RELEASE, "agent");
            asm volatile("s_waitcnt vmcnt(0)" ::: "memory");
            const unsigned og = xb_add(&bar[XB_TOP], 1u);
            const unsigned tg = og / nx;
            if (og + 1u == (tg + 1u) * nx) xb_add(&bar[XB_TOPGEN], 1u);
            else XB_SPIN(xb_ld(&bar[XB_TOPGEN]) == tg, bar);
            __builtin_amdgcn_fence(__ATOMIC_ACQUIRE, "agent");
            xb_add(&bar[XB_XGEN(bx_)], 1u);
            asm volatile("s_waitcnt vmcnt(0)" ::: "memory");
        } else {
            XB_SPIN(xb_ld(&bar[XB_XGEN(bx_)]) == gen, bar);
            __builtin_amdgcn_fence(__ATOMIC_ACQUIRE, "agent");
            asm volatile("s_waitcnt vmcnt(0)" ::: "memory");
        }
    }
    __syncthreads();
}

struct Args { const float* in[21]; float* out; unsigned char* ws; int never; int pad; };
constexpr size_t CTL_FLAG = 31744;
constexpr int STAGGER_SPIN = 0;

__global__ void __launch_bounds__(512, 2) fwd_megakernel(Args args) {
    extern __shared__ __attribute__((aligned(16))) unsigned char lds_raw[];
    LAS unsigned char* lds = (LAS unsigned char*)lds_raw;
    cg::grid_group grid = cg::this_grid();
    const int tid = threadIdx.x; const int wave = __builtin_amdgcn_readfirstlane(tid >> 6);
    const int G = gridDim.x, bx = blockIdx.x;
    const int grp = (bx >> 3) & 1, c = ((bx >> 4) << 3) | (bx & 7), Gg = G >> 1;
    volatile LAS unsigned* xst = (volatile LAS unsigned*)(lds + LDS_BYTES - 16);
    if (tid < 4) xst[tid] = 0u;
    __syncthreads();
    XcdBarrier xbar = xcd_barrier_post((unsigned*)args.ws + grp * 4096, xst, (unsigned)Gg);
    XcdBarrier gbar = xcd_barrier_post((unsigned*)args.ws + 2 * 4096, xst + 2, (unsigned)G);
#define GBAR() xcd_barrier(xbar)
    unsigned char* ws = args.ws;
    unsigned* flagw = (unsigned*)(ws + CTL_FLAG);
    const float* x_in = args.in[0]; const float* c_in = args.in[1]; const float* ctx_in = args.in[2]; const float* cctx_in = args.in[3];
    const float* w_mod = args.in[4]; const float* b_mod = args.in[5];
    const float* g_pre_mix = args.in[6]; const float* g_post_mix = args.in[7]; const float* g_pre_ffn = args.in[8]; const float* g_post_ffn = args.in[9];
    const float* we_in = args.in[10]; const float* we_out = args.in[11]; const float* we_qg = args.in[12]; const float* we_kg = args.in[13];
    const float* we_pool = args.in[14]; const float* we_pscale = args.in[15];
    const float* wo_in = args.in[16]; const float* wo_out = args.in[17]; const float* wo_sink = args.in[18];
    const float* w_f1 = args.in[19]; const float* w_f2 = args.in[20];
    float* out = args.out;
    float* MOD = (float*)(ws + WS_MOD); float* PART = (float*)(ws + WS_PART); float* PART2 = (float*)(ws + WS_PART2); bf16_t* Y2 = (bf16_t*)(ws + WS_Y2);
    float* XC = (float*)(ws + WS_XC);
    bf16_t* H = (bf16_t*)(ws + WS_H); bf16_t* Y = (bf16_t*)(ws + WS_Y);
    unsigned char* arena = ws + WS_Q + (size_t)grp * (216 * MiB);
    bf16_t* Ub = (bf16_t*)(arena + 108 * MiB) - (size_t)grp * GROWS * 512; bf16_t* MIX = (bf16_t*)(arena + 144 * MiB) - (size_t)grp * GROWS * 1024;
    bf16_t* ACT = (bf16_t*)arena - (size_t)grp * GROWS * FFN;
    const int gw = c * 8 + wave, ngw = Gg * 8;
    const int xl = c & 7, jl = c >> 3;

    for (int it = bx; it < 4 * 48; it += G) mod_item(it, c_in, cctx_in, w_mod, b_mod, MOD, lds);
    for (int l = 0; l < NLAYER; ++l) prep_layer(l, bx, G, ws, lds, we_in, we_out, we_pool, wo_in, wo_out, w_f1, w_f2);
    if (args.never) grid.sync();
    xcd_barrier(gbar);
    {
        RowArgs a{}; a.xinL = x_in; a.xinC = ctx_in; a.H = H; a.gpre = g_pre_mix; a.sh = MOD; a.sc = MOD + 1024; a.M = 36864; a.upd = 0; a.upd2 = 0; a.wr = 0; a.nxt = 1;
        row_phase(a, gw, ngw, grp);
    }
    GBAR();
    for (int l = 0; l < NLAYER; ++l) {
        const int li = l >> 1; const bool ev = (l & 1) == 0; const bool with_ctx = l < NLAYER - 1;
        const int Mlog = with_ctx ? 36864 : 32768;
        unsigned char* wl = ws + WS_W + (size_t)l * WL_STRIDE;
        float* MODl = MOD + (size_t)l * 33 * 6144;
        bf16_t* Qb = (bf16_t*)arena - (size_t)grp * GROWS * (ev ? 512 : 1024);
        bf16_t* Kb = (bf16_t*)(arena + 72 * MiB) - (size_t)(16 * grp) * KVR * (ev ? 128 : 256);
        bf16_t* Vt = (bf16_t*)(arena + 90 * MiB) - (size_t)(16 * grp) * (ev ? 2 : 4) * 64 * KVR;
        {
            pg8::Gemm g{H, (const bf16_t*)(wl + WL_IN), 36864, ev ? 1280 : 1536, 1024}; pg8::GroupOrder S; S.init(g.M, g.N, Gg, c, grp);
            LAS float* ropel = (LAS float*)(lds + 131072);
            rope_table(ropel); __syncthreads();
            EpiQKV E{ev ? 1 : 0, Qb, Kb, Vt, Ub, we_qg + li * 64, we_kg + li * 64, ropel, ev ? (unsigned*)nullptr : (unsigned*)(ws + 49152) + li * 640};
            pg8::gemm_phase<EpiQKV, pg8::GroupOrder>(lds, g, S, E);
        }
        GBAR();
        if (ev) {
            const int n_dense = 1024, n_ctx = with_ctx ? 128 : 0;
            float bref;
            { const int ln = tid & 63; float gq = fabsf(we_qg[li * 64 + ln]), gk = fabsf(we_kg[li * 64 + ln]);
#pragma unroll
              for (int o = 1; o < 64; o <<= 1) { gq = fmaxf(gq, __shfl_xor(gq, o)); gk = fmaxf(gk, __shfl_xor(gk, o)); }
              bref = __uint_as_float(__builtin_amdgcn_readfirstlane(__float_as_uint(64.0f * C2 * gq * gk * 1.02f + 0.25f))); }
            for (int u = c; u < n_dense + n_ctx; u += Gg) {
                int b, head, qrow0, na;
                if (u < n_dense) { int qb = u & 7; head = (u >> 3) & 7; int bl = u >> 6;
                    if (Gg == 128) { const int i = u >> 7, pr = (i >> 1) * 8 + xl, idx = (i & 1) * 16 + jl; bl = pr >> 1; head = (pr & 1) * 4 + (idx >> 3); qb = idx & 7; }
                    b = 16 * grp + bl; qrow0 = grp * GROWS + bl * SEQ + qb * 256; na = 32; }
                else { const int v = u - n_dense; head = v & 7; b = 16 * grp + (v >> 3); qrow0 = grp * GROWS + GLAT + (v >> 3) * CTX; na = 0; }
                const int kvh = head >> 2;
                if (bref <= 40.0f) attn_unit<false, false, true>(lds, Qb + (size_t)qrow0 * 512 + head * 64, 512, Kb + (size_t)b * KVR * 128 + kvh * 64, 128, Vt + (size_t)(b * 2 + kvh) * 64 * KVR,
                                                              MIX + (size_t)qrow0 * 1024 + head * 64, 0, na, 0, 0.f, bref);
                else attn_unit<false, false, false>(lds, Qb + (size_t)qrow0 * 512 + head * 64, 512, Kb + (size_t)b * KVR * 128 + kvh * 64, 128, Vt + (size_t)(b * 2 + kvh) * 64 * KVR,
                                                    MIX + (size_t)qrow0 * 1024 + head * 64, 0, na, 0, 0.f);
            }
            const int n_rt = Mlog / 128, n_pool = n_rt * 4;
            for (int u = c; u < n_pool; u += Gg) { const int tl = u % n_rt; const int rt = grp * (GROWS / 128) + tl;
                pool_unit(rt, u / n_rt, Ub, (const bf16_t*)(wl + WL_POOL), we_pscale + li * 512, MIX); }
        } else {
            const int n_win = 2048, n_ctx = with_ctx ? 256 : 0;
            for (int u = c; u < n_win + n_ctx; u += Gg) {
                if (u < n_win) {
                    int qb = u & 7, head = (u >> 3) & 15, bl = u >> 7;
                    if (Gg == 128) { const int i = u >> 7, pr = (i >> 1) * 8 + xl, idx = (i & 1) * 16 + jl; bl = pr >> 2; head = (pr & 3) * 4 + (idx >> 3); qb = ((idx & 7) + (i >> 1)) & 7; }
                    const int b = 16 * grp + bl; const int q0 = qb * 256, qrow0 = grp * GROWS + bl * SEQ + q0, kvh = head >> 2;
                    const int klo = (q0 - 128) < 0 ? 0 : (q0 - 128), khi = (q0 + 384) > SEQ ? SEQ : (q0 + 384);
                    const float sk = wo_sink[li * 16 + head] * LOG2E;
                    unsigned* mwp = (unsigned*)(ws + 49152) + li * 640 + b * 20;
                    const float mq2 = __uint_as_float(__builtin_amdgcn_readfirstlane(__hip_atomic_load(mwp + head, __ATOMIC_RELAXED, __HIP_MEMORY_SCOPE_AGENT)));
                    const float mk2 = __uint_as_float(__builtin_amdgcn_readfirstlane(__hip_atomic_load(mwp + 16 + kvh, __ATOMIC_RELAXED, __HIP_MEMORY_SCOPE_AGENT)));
                    const float refw = fmaxf(sqrtf(mq2 * mk2) * 1.02f + 0.25f, sk);
                    if (refw <= 50.0f && refw - sk <= 100.0f)
                        attn_unit<true, true, true>(lds, Qb + (size_t)qrow0 * 1024 + head * 64, 1024, Kb + (size_t)b * KVR * 256 + kvh * 64, 256, Vt + (size_t)(b * 4 + kvh) * 64 * KVR,
                                                    MIX + (size_t)qrow0 * 1024 + head * 64, klo >> 6, (khi - klo) >> 6, q0, sk, refw);
                    else
                    attn_unit<true, true>(lds, Qb + (size_t)qrow0 * 1024 + head * 64, 1024, Kb + (size_t)b * KVR * 256 + kvh * 64, 256, Vt + (size_t)(b * 4 + kvh) * 64 * KVR,
                                          MIX + (size_t)qrow0 * 1024 + head * 64, klo >> 6, (khi - klo) >> 6, q0, sk);
                } else {
                    const int v = u - n_win, head = v & 15, b = 16 * grp + (v >> 4); const int qrow0 = grp * GROWS + GLAT + (v >> 4) * CTX, kvh = head >> 2;
                    const float sk = wo_sink[li * 16 + head] * LOG2E;
                    attn_unit<false, true>(lds, Qb + (size_t)qrow0 * 1024 + head * 64, 1024, Kb + (size_t)b * KVR * 256 + kvh * 64, 256, Vt + (size_t)(b * 4 + kvh) * 64 * KVR,
                                           MIX + (size_t)qrow0 * 1024 + head * 64, 0, 0, 0, sk);
                }
            }
        }
        GBAR();
        {
            pg8::Gemm g{MIX, (const bf16_t*)(wl + WL_OUT), Mlog, 1024, 1024}; pg8::GroupOrder S; S.init(g.M, g.N, Gg, c, grp);
            EpiY E{Y, PART};
            pg8::gemm_phase<EpiY, pg8::GroupOrder>(lds, g, S, E);
        }
        GBAR();
        {
            RowArgs a{}; a.xinL = (l == 0) ? x_in : out; a.xinC = (l == 0) ? ctx_in : XC; a.xoutL = out; a.xoutC = XC;
            a.Y = Y; a.PART = PART; a.gate = MODl + 2048; a.gpost = g_post_mix + l * 1024;
            a.H = H; a.gpre = g_pre_ffn + l * 1024; a.sh = MODl + 3072; a.sc = MODl + 4096; a.M = Mlog; a.upd = 1; a.upd2 = 0; a.wr = 0; a.nxt = 1; a.xin16 = (l > 0) ? 1 : 0;
            row_phase(a, gw, ngw, grp);
        }
        GBAR();
        {
            pg8::Gemm g{H, (const bf16_t*)(wl + WL_F1), Mlog, 2 * FFN, 1024}; pg8::GroupOrder S; S.init(g.M, g.N, Gg, c, grp);
            EpiSwiGLU E{ACT};
            pg8::gemm_phase<EpiSwiGLU, pg8::GroupOrder>(lds, g, S, E);
        }
        GBAR();
        {
            pg8::Gemm g{ACT, (const bf16_t*)(wl + WL_F2), Mlog, 1024, FFN}; pg8::GroupOrder S; S.init(g.M, g.N, Gg, c, grp);
            EpiY E{Y2, PART2};
            pg8::gemm_phase<EpiY, pg8::GroupOrder>(lds, g, S, E);
        }
        GBAR();
        {
            RowArgs a{}; a.xinL = (l == 0) ? x_in : out; a.xinC = (l == 0) ? ctx_in : XC; a.xoutL = out; a.xoutC = XC;
            a.Y = Y; a.PART = PART; a.gate = MODl + 2048; a.gpost = g_post_mix + l * 1024;
            a.Y2 = Y2; a.PART2 = PART2; a.gate2 = MODl + 5120; a.gpost2 = g_post_ffn + l * 1024;
            a.H = H; a.gpre = g_pre_mix + (l + 1 < NLAYER ? l + 1 : l) * 1024; a.sh = MODl + 33 * 6144; a.sc = MODl + 33 * 6144 + 1024; a.M = Mlog; a.upd = 1; a.upd2 = 1; a.wr = 1; a.nxt = with_ctx ? 1 : 0; a.xin16 = (l > 0) ? 1 : 0; a.xout16 = with_ctx ? 1 : 0;
            row_phase(a, gw, ngw, grp);
        }
        if (l + 1 < NLAYER) GBAR();
    }
#undef GBAR
}

extern "C" void kernel_launch(void* const* d_in, const int* in_sizes, int n_in, void* d_out, int out_size, void* d_ws, size_t ws_size, hipStream_t stream) {
    static int grid = 0;
    if (grid == 0) {
        if (n_in != 21 || out_size != NL * DM || ws_size < WS_END) { fprintf(stderr, "kernel_launch: unexpected shapes (n_in %d out %d ws %zu)\n", n_in, out_size, ws_size); grid = -1; return; }
        int dev = 0, cus = 0, per_cu = 0;
        (void)hipGetDevice(&dev);
        (void)hipDeviceGetAttribute(&cus, hipDeviceAttributeMultiprocessorCount, dev);
        if (hipFuncSetAttribute((const void*)fwd_megakernel, hipFuncAttributeMaxDynamicSharedMemorySize, LDS_BYTES) != hipSuccess) { fprintf(stderr, "kernel_launch: hipFuncSetAttribute failed\n"); }
        if (hipOccupancyMaxActiveBlocksPerMultiprocessor(&per_cu, (const void*)fwd_megakernel, 512, LDS_BYTES) != hipSuccess || per_cu < 1) { fprintf(stderr, "kernel_launch: occupancy query says %d\n", per_cu); per_cu = 1; }
        (void)hipGetLastError();
        if (per_cu > 1) per_cu = 1;
        grid = (cus * per_cu) & ~1;
    }
    if (grid < 0) return;
    if (hipMemsetAsync(d_ws, 0, 57344, stream) != hipSuccess) { fprintf(stderr, "kernel_launch: memset of barrier words failed\n"); return; }
    Args a{};
    for (int i = 0; i < 21; ++i) a.in[i] = (const float*)d_in[i];
    a.out = (float*)d_out; a.ws = (unsigned char*)d_ws;
    void* kargs[] = {&a};
    hipError_t e = hipLaunchCooperativeKernel((const void*)fwd_megakernel, dim3(grid), dim3(512), kargs, LDS_BYTES, stream);
    if (e != hipSuccess) fprintf(stderr, "cooperative launch failed: %s (grid %d)\n", hipGetErrorString(e), grid);
}
```

```cpp
#include <hip/hip_runtime.h>
#include <hip/hip_cooperative_groups.h>
#include <cstdio>
#include <cstdint>
namespace cg = cooperative_groups;

#define DI __device__ __forceinline__
#define LAS __attribute__((address_space(3)))
typedef unsigned short bf16_t;
typedef short bf16x8 __attribute__((ext_vector_type(8)));
typedef short s16x4 __attribute__((ext_vector_type(4)));
typedef float f32x4 __attribute__((ext_vector_type(4)));
typedef float f32x16 __attribute__((ext_vector_type(16)));
typedef unsigned u32x4 __attribute__((ext_vector_type(4)));
typedef unsigned u32x2 __attribute__((ext_vector_type(2)));
typedef float f32x2_t __attribute__((ext_vector_type(2)));
typedef __bf16 bf16x2_t __attribute__((ext_vector_type(2)));

DI unsigned cvtpk(float lo, float hi) { f32x2_t v = {lo, hi}; bf16x2_t b = __builtin_convertvector(v, bf16x2_t); return __builtin_bit_cast(unsigned, b); }
DI float bf2f(unsigned short b) { return __uint_as_float(((unsigned)b) << 16); }
DI float bflo(unsigned w) { return __uint_as_float(w << 16); }
DI float bfhi(unsigned w) { return __uint_as_float(w & 0xffff0000u); }

constexpr int DM = 1024, NBATCH = 32, SEQ = 2048, CTX = 256, NLAYER = 4;
constexpr int NL = NBATCH * SEQ;
constexpr int NC = NBATCH * CTX;
constexpr int NT = NL + NC;
constexpr int GROWS = 36864, GLAT = 32768, GPAN = 144;
constexpr int KVR = SEQ + CTX;
constexpr int FFN = 2816;
constexpr float EPS = 1e-6f;
constexpr float LOG2E = 1.4426950408889634f;
constexpr float C2 = 0.125f * LOG2E;

constexpr size_t MiB = 1u << 20;
constexpr size_t WS_MOD = 1 * MiB;
constexpr size_t WS_ROPE = 5 * MiB;
constexpr size_t WS_PART = 6 * MiB;
constexpr size_t WS_PART2 = 11 * MiB;
constexpr size_t WS_W = 16 * MiB;
constexpr size_t WL_IN = 0, WL_OUT = 3 * MiB, WL_POOL = 5 * MiB, WL_F1 = 6 * MiB, WL_F2 = 17 * MiB, WL_STRIDE = 24 * MiB;
constexpr size_t WS_XC = 112 * MiB;
constexpr size_t WS_H = 144 * MiB;
constexpr size_t WS_Y = 288 * MiB;
constexpr size_t WS_Q = 432 * MiB;
constexpr size_t WS_K = 576 * MiB;
constexpr size_t WS_VT = 612 * MiB;
constexpr size_t WS_U = 648 * MiB;
constexpr size_t WS_MIX = 720 * MiB;
constexpr size_t WS_ACT = 432 * MiB;
constexpr size_t WS_Y2 = 864 * MiB;
constexpr size_t WS_END = 1008 * MiB;
constexpr int LDS_BYTES = 147456;

namespace pg8 {
#define PG8_LAS __attribute__((address_space(3)))
constexpr int BM = 256, BK = 64, HALF = 128, HTB = HALF * BK * 2, STAGE_BYTES = 8 * HTB, NXCD = 8, WGM = 4;
__host__ __device__ __forceinline__ int lds_byte(int r, int c) { const int st = (r >> 4) * 2 + (c >> 5), rr = r & 15, cc = c & 31, ob = rr * 64 + cc * 2; return st * 1024 + (ob ^ (((ob >> 9) & 1) << 5)); }
__host__ __device__ __forceinline__ void stage_rc(int b, int& R, int& C) { const int st = b / 1024, sb = b % 1024, swz = sb ^ (((sb >> 9) & 1) << 5); R = (st >> 1) * 16 + swz / 64; C = (st & 1) * 32 + (swz % 64) / 2; }
struct Unit { int pm, pn; };
struct Gemm { const bf16_t* A; const bf16_t* Bt; int M, N, K; };
struct StaticOrder {
    int nM, nN, nwg, G, c;
    __host__ __device__ void init(int M, int N, int G_, int c_) { nM = M / BM; nN = N / BM; nwg = nM * nN; G = G_; c = c_; }
    __host__ __device__ bool next(int i, Unit& u) const {
        const long L = (long)i * G + c; if (L >= nwg) return false;
        int wgid = (int)L; { const int q = nwg / NXCD, r = nwg % NXCD, xcd = wgid % NXCD, off = wgid / NXCD; wgid = (xcd < r ? xcd * (q + 1) : r * (q + 1) + (xcd - r) * q) + off; }
        const int nig = WGM * nN, gid = wgid / nig, fm = gid * WGM, gsz = (nM - fm) < WGM ? (nM - fm) : WGM;
        u.pm = fm + ((wgid % nig) % gsz); u.pn = (wgid % nig) / gsz; return true;
    }
};
struct GroupOrder {
    StaticOrder base; int g;
    __host__ __device__ void init(int Mlog, int N, int Gg, int c, int g_) { base.init(Mlog, N, Gg, c); g = g_; }
    __host__ __device__ bool next(int i, Unit& u) const {
        if (!base.next(i, u)) return false;
        u.pm += 144 * g; return true;
    }
};
template <class Epi, class Sched>
__device__ __forceinline__ void gemm_phase(PG8_LAS unsigned char* lds, const Gemm g, const Sched& S, const Epi& E) {
    int tid_ = threadIdx.x; asm volatile("" : "+v"(tid_));
    const int tid = tid_, wid = __builtin_amdgcn_readfirstlane(tid >> 6), lane = tid & 63, wr = wid >> 2, wc = wid & 3, fr = lane & 15, fq = lane >> 4;
    const int K = g.K, nt = K / BK;
    unsigned voffA[2], voffB[2];
#pragma unroll
    for (int i = 0; i < 2; ++i) { int R, C; stage_rc(tid * 16 + i * 8192, R, C); voffA[i] = (unsigned)(R * K + C) * 2u; voffB[i] = voffA[i]; }
    const size_t kstep = (size_t)(BK * 2);
    const size_t hstep = (size_t)HALF * K * 2;
    const size_t tstep = 2 * hstep;
    const unsigned ldsw = (unsigned)wid * 1024u;
    const int aoff = lds_byte(wr * 64 + fr, fq * 8), boff = lds_byte(wc * 32 + fr, fq * 8);
#define PG8_SA(b, h) (((b) * 2 + (h)) * HTB)
#define PG8_SB(b, h) ((4 + (b) * 2 + (h)) * HTB)
#define PG8_STAGE(bufoff, gbase, voff) do { _Pragma("unroll") for (int _i = 0; _i < 2; ++_i) \
        __builtin_amdgcn_global_load_lds((const unsigned*)((const char*)(gbase) + (voff)[_i]), (PG8_LAS unsigned*)(lds + (bufoff) + ldsw + _i * 8192), 16, 0, 0); } while (0)
#define PG8_LDA(dst, b, h) do { _Pragma("unroll") for (int m = 0; m < 4; ++m) _Pragma("unroll") for (int k = 0; k < 2; ++k) dst[m][k] = *(const PG8_LAS bf16x8*)(lds + PG8_SA(b, h) + aoff + m * 2048 + k * 1024); } while (0)
#define PG8_LDB(dst, b, h) do { _Pragma("unroll") for (int n = 0; n < 2; ++n) _Pragma("unroll") for (int k = 0; k < 2; ++k) dst[n][k] = *(const PG8_LAS bf16x8*)(lds + PG8_SB(b, h) + boff + n * 2048 + k * 1024); } while (0)
#define PG8_MMA(ai, bj, At, Bt) do { __builtin_amdgcn_s_setprio(1); _Pragma("unroll") for (int m = 0; m < 4; ++m) _Pragma("unroll") for (int n = 0; n < 2; ++n) _Pragma("unroll") for (int k = 0; k < 2; ++k) \
        acc[ai][bj][m][n] = __builtin_amdgcn_mfma_f32_16x16x32_bf16(Bt[n][k], At[m][k], acc[ai][bj][m][n], 0, 0, 0); __builtin_amdgcn_s_setprio(0); } while (0)
#define PG8_WAIT_V(n) asm volatile("s_waitcnt vmcnt(" #n ")" ::: "memory")
#define PG8_WAIT_L(n) asm volatile("s_waitcnt lgkmcnt(" #n ")" ::: "memory")
#define PG8_BAR __builtin_amdgcn_s_barrier()
#define PG8_SCHED __builtin_amdgcn_sched_barrier(0)
    Unit cur, nxt; int ui = 0;
    if (!S.next(0, cur)) return;
    f32x4 acc[2][2][4][2];
#pragma unroll
    for (int a = 0; a < 2; ++a)
#pragma unroll
        for (int b = 0; b < 2; ++b)
#pragma unroll
            for (int m = 0; m < 4; ++m)
#pragma unroll
                for (int n = 0; n < 2; ++n) acc[a][b][m][n] = (f32x4){0.f, 0.f, 0.f, 0.f};
    bf16x8 At[4][2], B0[2][2], B1[2][2];
    const char* cA = (const char*)g.A + (size_t)cur.pm * tstep; const char* cB = (const char*)g.Bt + (size_t)cur.pn * tstep;
    PG8_STAGE(PG8_SB(0, 0), cB, voffB); PG8_STAGE(PG8_SB(0, 1), cB + hstep, voffB); PG8_STAGE(PG8_SA(0, 0), cA, voffA); PG8_STAGE(PG8_SA(0, 1), cA + hstep, voffA);
    if (wr == 1) PG8_BAR;
    PG8_WAIT_V(2); PG8_BAR;
    PG8_STAGE(PG8_SB(1, 0), cB + kstep, voffB); PG8_STAGE(PG8_SA(1, 0), cA + kstep, voffA); PG8_STAGE(PG8_SB(1, 1), cB + hstep + kstep, voffB);
    PG8_WAIT_V(6); PG8_BAR;
    for (;;) {
        const bool has_next = S.next(ui + 1, nxt);
        const char* nA = has_next ? (const char*)g.A + (size_t)nxt.pm * tstep : cA; const char* nB = has_next ? (const char*)g.Bt + (size_t)nxt.pn * tstep : cB;
        for (int t = 0; t < nt; t += 2) {
            const bool last = (t == nt - 2);
            const char* a1 = cA + (size_t)(t + 1) * kstep;
            const char* a2 = last ? nA : cA + (size_t)(t + 2) * kstep; const char* b2 = last ? nB : cB + (size_t)(t + 2) * kstep;
            const char* a3 = a2 + kstep; const char* b3 = b2 + kstep;
            PG8_LDB(B0, 0, 0); PG8_LDB(B1, 0, 1); PG8_SCHED; PG8_LDA(At, 0, 0); PG8_STAGE(PG8_SA(1, 1), a1 + hstep, voffA);
            PG8_WAIT_V(8); PG8_WAIT_L(0); PG8_BAR; PG8_MMA(0, 0, At, B0); PG8_MMA(0, 1, At, B1); PG8_BAR; PG8_SCHED;
            PG8_LDA(At, 0, 1); PG8_STAGE(PG8_SB(0, 0), b2, voffB); PG8_STAGE(PG8_SB(0, 1), b2 + hstep, voffB); PG8_STAGE(PG8_SA(0, 0), a2, voffA);
            PG8_WAIT_V(8); PG8_WAIT_L(0); PG8_BAR; PG8_MMA(1, 0, At, B0); PG8_MMA(1, 1, At, B1); PG8_BAR; PG8_SCHED;
            PG8_LDB(B0, 1, 0); PG8_LDB(B1, 1, 1); PG8_SCHED; PG8_LDA(At, 1, 0); PG8_STAGE(PG8_SA(0, 1), a2 + hstep, voffA);
            PG8_WAIT_V(8); PG8_WAIT_L(0); PG8_BAR; PG8_MMA(0, 0, At, B0); PG8_MMA(0, 1, At, B1); PG8_BAR; PG8_SCHED;
            PG8_LDA(At, 1, 1); PG8_STAGE(PG8_SB(1, 0), b3, voffB); PG8_STAGE(PG8_SB(1, 1), b3 + hstep, voffB); PG8_STAGE(PG8_SA(1, 0), a3, voffA);
            PG8_WAIT_V(8); PG8_WAIT_L(0); PG8_BAR; PG8_MMA(1, 0, At, B0); PG8_MMA(1, 1, At, B1); PG8_BAR; PG8_SCHED;
        }
        if (wr == 0) PG8_BAR;
        E(acc, cur, wr, wc, fr, fq);
        if (!has_next) break;
#pragma unroll
        for (int a = 0; a < 2; ++a)
#pragma unroll
            for (int b = 0; b < 2; ++b)
#pragma unroll
                for (int m = 0; m < 4; ++m)
#pragma unroll
                    for (int n = 0; n < 2; ++n) acc[a][b][m][n] = (f32x4){0.f, 0.f, 0.f, 0.f};
        cur = nxt; cA = nA; cB = nB; ++ui;
        if (wr == 1) PG8_BAR;
    }
    PG8_WAIT_V(0);
    PG8_BAR;
#undef PG8_SA
#undef PG8_SB
#undef PG8_STAGE
#undef PG8_LDA
#undef PG8_LDB
#undef PG8_MMA
#undef PG8_WAIT_V
#undef PG8_WAIT_L
#undef PG8_BAR
#undef PG8_SCHED
}
}

struct EpiQKV {
    int even;
    bf16_t* Q; bf16_t* Kb; bf16_t* Vt; bf16_t* U;
    const float* qg; const float* kg; const LAS float* rope; unsigned* maxw;
    DI void operator()(const f32x4 (&acc)[2][2][4][2], const pg8::Unit& u, int wr, int wc, int fr, int fq) const {
        int kind, head;
        const int pn = u.pn;
        if (even) { if (pn < 2) { kind = 0; head = pn * 4 + wc; } else if (pn == 2) { if (wc < 2) { kind = 1; head = wc; } else { kind = 2; head = wc - 2; } } else { kind = 3; head = (pn - 3) * 4 + wc; } }
        else { if (pn < 4) { kind = 0; head = pn * 4 + wc; } else if (pn == 4) { kind = 1; head = wc; } else { kind = 2; head = wc; } }
        const int qw = even ? 512 : 1024, kvw = even ? 128 : 256, nkv = even ? 2 : 4;
        const int gq = u.pm / GPAN, pl = u.pm - gq * GPAN;
        const bool lat = pl < 128;
        int b, pos0;
        if (lat) { b = 16 * gq + (pl >> 3); pos0 = (pl & 7) * 256; } else { b = 16 * gq + (pl - 128); pos0 = SEQ; }
        const int half = fq >> 1, f0 = 8 * (fq & 1);
        const int dbase = 32 * half + f0;
        f32x4 gn[2][2];
        const bool donorm = even && kind <= 1;
        if (donorm) { const float* gp = (kind == 0) ? qg : kg;
#pragma unroll
            for (int bj = 0; bj < 2; ++bj)
#pragma unroll
                for (int n = 0; n < 2; ++n) gn[bj][n] = *(const f32x4*)(gp + dbase + 16 * bj + 4 * n); }
        const float qs = (kind == 0) ? C2 : 1.0f;
        float rmaxn = 0.f;
#pragma unroll
        for (int ai = 0; ai < 2; ++ai)
#pragma unroll
            for (int m = 0; m < 4; ++m) {
                const int rl = 128 * ai + 64 * wr + 16 * m + fr;
                const size_t grow = (size_t)u.pm * 256 + rl;
                const int pos = pos0 + rl;
                f32x4 v[2][2];
#pragma unroll
                for (int bj = 0; bj < 2; ++bj)
#pragma unroll
                    for (int n = 0; n < 2; ++n) v[bj][n] = acc[ai][bj][m][n];
                if (kind <= 1) {
                    if (donorm) {
                        float ss = 0.f;
#pragma unroll
                        for (int bj = 0; bj < 2; ++bj)
#pragma unroll
                            for (int n = 0; n < 2; ++n) ss += (v[bj][n][0] * v[bj][n][0] + v[bj][n][1] * v[bj][n][1]) + (v[bj][n][2] * v[bj][n][2] + v[bj][n][3] * v[bj][n][3]);
                        ss += __shfl_xor(ss, 16); ss += __shfl_xor(ss, 32);
                        const float rstd = rsqrtf(ss * (1.0f / 64.0f) + EPS);
#pragma unroll
                        for (int bj = 0; bj < 2; ++bj)
#pragma unroll
                            for (int n = 0; n < 2; ++n) v[bj][n] = v[bj][n] * rstd * gn[bj][n];
                    }
                    if (lat) {
                        const int p = half ? (pos & 63) : (pos >> 6);
                        const LAS f32x4* rp = (const LAS f32x4*)(rope + (p * 16 + f0) * 2);
#pragma unroll
                        for (int n = 0; n < 2; ++n) {
                            const f32x4 cs0 = rp[2 * n], cs1 = rp[2 * n + 1];
                            const float c[4] = {cs0[0], cs0[2], cs1[0], cs1[2]}, s[4] = {cs0[1], cs0[3], cs1[1], cs1[3]};
#pragma unroll
                            for (int i = 0; i < 4; ++i) { const float a1 = v[0][n][i], a2 = v[1][n][i]; v[0][n][i] = a1 * c[i] - a2 * s[i]; v[1][n][i] = a2 * c[i] + a1 * s[i]; }
                        }
                    }
                    if (maxw) { float nn = 0.f;
#pragma unroll
                        for (int bj = 0; bj < 2; ++bj)
#pragma unroll
                            for (int n = 0; n < 2; ++n) nn += (v[bj][n][0] * v[bj][n][0] + v[bj][n][1] * v[bj][n][1]) + (v[bj][n][2] * v[bj][n][2] + v[bj][n][3] * v[bj][n][3]);
                        nn += __shfl_xor(nn, 16); nn += __shfl_xor(nn, 32); rmaxn = fmaxf(rmaxn, nn * qs * qs); }
                    bf16_t* dst = (kind == 0) ? (Q + grow * qw + head * 64) : (Kb + ((size_t)b * KVR + pos) * kvw + head * 64);
#pragma unroll
                    for (int bj = 0; bj < 2; ++bj) {
                        u32x4 w; w.x = cvtpk(v[bj][0][0] * qs, v[bj][0][1] * qs); w.y = cvtpk(v[bj][0][2] * qs, v[bj][0][3] * qs);
                        w.z = cvtpk(v[bj][1][0] * qs, v[bj][1][1] * qs); w.w = cvtpk(v[bj][1][2] * qs, v[bj][1][3] * qs);
                        *(u32x4*)(dst + dbase + 16 * bj) = w;
                    }
                } else if (kind == 2) {
                    const int posp = (pos & ~15) | (pos & 3) | ((pos & 4) << 1) | ((pos & 8) >> 1);
                    bf16_t* dst = Vt + ((size_t)(b * nkv + head) * 64) * KVR + posp;
#pragma unroll
                    for (int bj = 0; bj < 2; ++bj)
#pragma unroll
                        for (int n = 0; n < 2; ++n)
#pragma unroll
                            for (int i = 0; i < 4; ++i) { const int d = dbase + 16 * bj + 4 * n + i; dst[(size_t)d * KVR] = (bf16_t)(cvtpk(v[bj][n][i], 0.f) & 0xffffu); }
                } else {
                    bf16_t* dst = U + grow * 512 + head * 64;
#pragma unroll
                    for (int bj = 0; bj < 2; ++bj) {
                        u32x4 w; w.x = cvtpk(v[bj][0][0], v[bj][0][1]); w.y = cvtpk(v[bj][0][2], v[bj][0][3]);
                        w.z = cvtpk(v[bj][1][0], v[bj][1][1]); w.w = cvtpk(v[bj][1][2], v[bj][1][3]);
                        *(u32x4*)(dst + dbase + 16 * bj) = w;
                    }
                }
            }
        if (maxw && kind <= 1) {
            rmaxn = fmaxf(rmaxn, __shfl_xor(rmaxn, 1)); rmaxn = fmaxf(rmaxn, __shfl_xor(rmaxn, 2)); rmaxn = fmaxf(rmaxn, __shfl_xor(rmaxn, 4)); rmaxn = fmaxf(rmaxn, __shfl_xor(rmaxn, 8));
            if (fr == 0 && fq == 0) __hip_atomic_fetch_max(maxw + b * 20 + (kind == 0 ? head : 16 + head), __float_as_uint(rmaxn), __ATOMIC_RELAXED, __HIP_MEMORY_SCOPE_AGENT);
        }
    }
};

struct EpiY {
    bf16_t* Y; float* PART;
    DI void operator()(const f32x4 (&acc)[2][2][4][2], const pg8::Unit& u, int wr, int wc, int fr, int fq) const {
#pragma unroll
        for (int ai = 0; ai < 2; ++ai)
#pragma unroll
            for (int m = 0; m < 4; ++m) {
                const size_t row = (size_t)u.pm * 256 + 128 * ai + 64 * wr + 16 * m + fr;
                float ss = 0.f;
#pragma unroll
                for (int bj = 0; bj < 2; ++bj) {
                    const f32x4 v0 = acc[ai][bj][m][0], v1 = acc[ai][bj][m][1];
                    ss += (v0[0] * v0[0] + v0[1] * v0[1]) + (v0[2] * v0[2] + v0[3] * v0[3]) + (v1[0] * v1[0] + v1[1] * v1[1]) + (v1[2] * v1[2] + v1[3] * v1[3]);
                    u32x4 w; w.x = cvtpk(v0[0], v0[1]); w.y = cvtpk(v0[2], v0[3]); w.z = cvtpk(v1[0], v1[1]); w.w = cvtpk(v1[2], v1[3]);
                    *(u32x4*)(Y + row * 1024 + u.pn * 256 + 128 * bj + 32 * wc + 8 * fq) = w;
                }
                ss += __shfl_xor(ss, 16); ss += __shfl_xor(ss, 32);
                if (fq == 0) PART[row * 16 + u.pn * 4 + wc] = ss;
            }
    }
};

struct EpiSwiGLU {
    bf16_t* ACT;
    DI void operator()(const f32x4 (&acc)[2][2][4][2], const pg8::Unit& u, int wr, int wc, int fr, int fq) const {
#pragma unroll
        for (int ai = 0; ai < 2; ++ai)
#pragma unroll
            for (int m = 0; m < 4; ++m) {
                const size_t row = (size_t)u.pm * 256 + 128 * ai + 64 * wr + 16 * m + fr;
                float o[2][4];
#pragma unroll
                for (int n = 0; n < 2; ++n)
#pragma unroll
                    for (int i = 0; i < 4; ++i) { const float gt = acc[ai][0][m][n][i], up = acc[ai][1][m][n][i]; o[n][i] = gt * up * __builtin_amdgcn_rcpf(1.0f + __builtin_amdgcn_exp2f(-LOG2E * gt)); }
                u32x4 w; w.x = cvtpk(o[0][0], o[0][1]); w.y = cvtpk(o[0][2], o[0][3]); w.z = cvtpk(o[1][0], o[1][1]); w.w = cvtpk(o[1][2], o[1][3]);
                *(u32x4*)(ACT + row * FFN + u.pn * 128 + 32 * wc + 8 * fq) = w;
            }
    }
};

DI int newrow(int type, int o) {
    if (type == 0) { const int ol = o & 255, bj = ol >> 7, wc = (ol >> 5) & 3, fq = (ol >> 3) & 3, n = (ol >> 2) & 1, i = ol & 3; return (o & ~255) + 128 * bj + 32 * wc + 16 * n + 4 * fq + i; }
    if (type == 1) { const int ol = o & 255, wc = ol >> 6, d = ol & 63, fq = 2 * (d >> 5) + ((d >> 3) & 1), bj = (d >> 4) & 1, n = (d >> 2) & 1, i = d & 3; return (o & ~255) + 128 * bj + 32 * wc + 16 * n + 4 * fq + i; }
    if (type == 2) { const int isu = o >= FFN ? 1 : 0, j = o - FFN * isu, pn = j >> 7, jj = j & 127, wc = jj >> 5, fq = (jj >> 3) & 3, n = (jj >> 2) & 1, i = jj & 3; return pn * 256 + 128 * isu + 32 * wc + 16 * n + 4 * fq + i; }
    return o;
}
DI void prep_item(const float* W, int K, int N, bf16_t* WT, int type, int item, LAS float* scr) {
    int tid_ = threadIdx.x; asm volatile("" : "+v"(tid_)); const int tid = tid_;
    const int nblk = N / 64, kb = item / nblk, nb = item % nblk, k0 = 64 * kb, n0 = 64 * nb;
    { const int r = tid >> 4, c4 = (tid & 15) * 4;
#pragma unroll
      for (int p = 0; p < 2; ++p) { const int kk = r + 32 * p; const f32x4 v = *(const f32x4*)(W + (size_t)(k0 + kk) * N + n0 + c4);
          scr[kk * 65 + c4 + 0] = v[0]; scr[kk * 65 + c4 + 1] = v[1]; scr[kk * 65 + c4 + 2] = v[2]; scr[kk * 65 + c4 + 3] = v[3]; } }
    __syncthreads();
    { const int n = tid >> 3, kc = (tid & 7) * 8; const LAS float* s = scr + kc * 65 + n;
      u32x4 o; o.x = cvtpk(s[0 * 65], s[1 * 65]); o.y = cvtpk(s[2 * 65], s[3 * 65]); o.z = cvtpk(s[4 * 65], s[5 * 65]); o.w = cvtpk(s[6 * 65], s[7 * 65]);
      *(u32x4*)(WT + (size_t)newrow(type, n0 + n) * K + k0 + kc) = o; }
    __syncthreads();
}

DI void prep_layer(int l, int worker, int nworkers, unsigned char* ws, LAS unsigned char* lds, const float* we_in, const float* we_out, const float* we_pool,
                   const float* wo_in, const float* wo_out, const float* w_f1, const float* w_f2) {
    constexpr int I_IN = 384, I_OUT = 256, I_POOL = 16, I_F1 = 1408, I_F2 = 704, I_LAYER = I_IN + I_OUT + I_POOL + I_F1 + I_F2;
    const int li = l >> 1; const bool ev = (l & 1) == 0;
    unsigned char* wl = ws + WS_W + (size_t)l * WL_STRIDE;
    LAS float* scr = (LAS float*)lds;
    for (int it = worker; it < I_LAYER; it += nworkers) {
        int r = it;
        if (r < I_IN) { if (ev) { if (r < 320) prep_item(we_in + (size_t)li * 1024 * 1280, 1024, 1280, (bf16_t*)(wl + WL_IN), 1, r, scr); }
                        else prep_item(wo_in + (size_t)li * 1024 * 1536, 1024, 1536, (bf16_t*)(wl + WL_IN), 1, r, scr); continue; } r -= I_IN;
        if (r < I_OUT) { prep_item((ev ? we_out : wo_out) + (size_t)li * 1024 * 1024, 1024, 1024, (bf16_t*)(wl + WL_OUT), 0, r, scr); continue; } r -= I_OUT;
        if (r < I_POOL) { if (ev) { const int gq = r >> 2; prep_item(we_pool + ((size_t)li * 4 + gq) * 128 * 128, 128, 128, (bf16_t*)(wl + WL_POOL) + (size_t)gq * 128 * 128, 3, r & 3, scr); } continue; } r -= I_POOL;
        if (r < I_F1) { prep_item(w_f1 + (size_t)l * 1024 * 5632, 1024, 5632, (bf16_t*)(wl + WL_F1), 2, r, scr); continue; } r -= I_F1;
        prep_item(w_f2 + (size_t)l * FFN * 1024, FFN, 1024, (bf16_t*)(wl + WL_F2), 0, r, scr);
    }
}

DI void mod_item(int item, const float* c, const float* cctx, const float* w_mod, const float* b_mod, float* MOD, LAS unsigned char* lds) {
    const int tid = threadIdx.x;
    const int l = item / 48, n0 = (item % 48) * 128;
    LAS float* S = (LAS float*)lds;
    for (int idx = tid; idx < 33 * 1024; idx += 512) { const int b = idx >> 10, k = idx & 1023; const float cv = (b < 32) ? c[b * 1024 + k] : cctx[k]; S[idx] = cv / (1.0f + __expf(-cv)); }
    __syncthreads();
    const int lane = tid & 63, kq = tid >> 6;
    float acc0[33], acc1[33];
#pragma unroll
    for (int b = 0; b < 33; ++b) { acc0[b] = 0.f; acc1[b] = 0.f; }
    const float* W = w_mod + (size_t)l * 1024 * 6144 + n0 + lane;
#pragma unroll 2
    for (int k = kq * 128; k < kq * 128 + 128; k += 4) {
        float wa[4], wb[4];
#pragma unroll
        for (int i = 0; i < 4; ++i) { wa[i] = __builtin_nontemporal_load(W + (size_t)(k + i) * 6144); wb[i] = __builtin_nontemporal_load(W + (size_t)(k + i) * 6144 + 64); }
#pragma unroll
        for (int b = 0; b < 33; ++b) { const f32x4 sv = *(const LAS f32x4*)(S + b * 1024 + k);
            acc0[b] += (sv[0] * wa[0] + sv[1] * wa[1]) + (sv[2] * wa[2] + sv[3] * wa[3]);
            acc1[b] += (sv[0] * wb[0] + sv[1] * wb[1]) + (sv[2] * wb[2] + sv[3] * wb[3]); }
    }
    __syncthreads();
    LAS float* red = (LAS float*)lds;
#pragma unroll
    for (int b = 0; b < 33; ++b) { red[(kq * 33 + b) * 128 + lane] = acc0[b]; red[(kq * 33 + b) * 128 + 64 + lane] = acc1[b]; }
    __syncthreads();
    for (int idx = tid; idx < 33 * 128; idx += 512) { const int b = idx >> 7, cc = idx & 127;
        float v = 0.f;
#pragma unroll
        for (int q = 0; q < 8; ++q) v += red[(q * 33 + b) * 128 + cc];
        MOD[((size_t)l * 33 + b) * 6144 + n0 + cc] = v + b_mod[l * 6144 + n0 + cc]; }
    __syncthreads();
}

DI void rope_table(LAS float* rope) {
    for (int idx = threadIdx.x; idx < 1024; idx += 512) {
        const int pos = idx >> 4, f = idx & 15;
        double fr = 1.0; const double q = 0.56234132519034908;
        for (int i = 0; i < f; ++i) fr *= q;
        const float ang = (float)pos * (float)fr;
        double r = (double)ang; const double twopi = 6.283185307179586476925;
        const double kk = __builtin_rint(r * (1.0 / twopi)); r -= kk * twopi;
        const double r2 = r * r; double s = r, ts = r, cc = 1.0, tc = 1.0;
#pragma unroll
        for (int n = 1; n <= 14; ++n) { ts *= r2 * (-1.0 / (double)((2 * n) * (2 * n + 1))); s += ts; tc *= r2 * (-1.0 / (double)((2 * n - 1) * (2 * n))); cc += tc; }
        rope[idx * 2] = (float)cc; rope[idx * 2 + 1] = (float)s;
    }
}

DI float wave_sum(float v) {
#pragma unroll
    for (int o = 1; o < 64; o <<= 1) v += __shfl_xor(v, o);
    return v;
}
struct RowArgs {
    const float* xinL; const float* xinC; float* xoutL; float* xoutC;
    const bf16_t* Y; const float* PART; const float* gate; const float* gpost;
    const bf16_t* Y2; const float* PART2; const float* gate2; const float* gpost2;
    bf16_t* H; const float* gpre; const float* sh; const float* sc;
    int M; int upd; int upd2; int wr; int nxt; int xin16; int xout16;
};
template <int NR>
DI void row_work(const RowArgs& a, int row0, int lane) {
    const int gq = row0 / GROWS, rl0 = row0 - gq * GROWS; const bool lat = rl0 < GLAT;
    const int bb = lat ? (16 * gq + (rl0 >> 11)) : 32;
    const size_t xrow0 = lat ? (size_t)(gq * GLAT + rl0) : (size_t)(gq * 4096 + rl0 - GLAT);
    const float* xi0 = (lat ? a.xinL : a.xinC) + xrow0 * 1024;
    f32x4 x[NR][4];
    if (a.xin16) {
#pragma unroll
        for (int r = 0; r < NR; ++r)
#pragma unroll
            for (int j = 0; j < 4; ++j) { const u32x2 xb = __builtin_nontemporal_load((const u32x2*)((const bf16_t*)(xi0 + (size_t)r * 1024) + 4 * lane + 256 * j));
                x[r][j] = (f32x4){bflo(xb.x), bfhi(xb.x), bflo(xb.y), bfhi(xb.y)}; }
    } else {
#pragma unroll
        for (int r = 0; r < NR; ++r)
#pragma unroll
            for (int j = 0; j < 4; ++j) x[r][j] = __builtin_nontemporal_load((const f32x4*)(xi0 + (size_t)r * 1024 + 4 * lane + 256 * j));
    }
#pragma unroll
    for (int br = 0; br < 2; ++br) {
        if (br == 0 ? !a.upd : !a.upd2) continue;
        const bf16_t* Yp = (br == 0 ? a.Y : a.Y2) + (size_t)row0 * 1024 + 4 * lane; const float* Pp = (br == 0 ? a.PART : a.PART2) + (size_t)row0 * 16 + (lane & 15);
        const float* gatep = (br == 0 ? a.gate : a.gate2) + (size_t)bb * 6144 + 4 * lane; const float* gpostp = (br == 0 ? a.gpost : a.gpost2) + 4 * lane;
        u32x2 yb[NR][4]; float ps[NR];
#pragma unroll
        for (int r = 0; r < NR; ++r) {
#pragma unroll
            for (int j = 0; j < 4; ++j) yb[r][j] = __builtin_nontemporal_load((const u32x2*)(Yp + (size_t)r * 1024 + 256 * j));
            ps[r] = Pp[r * 16];
        }
        float rstd[NR];
#pragma unroll
        for (int r = 0; r < NR; ++r) {
            float ss = ps[r]; ss += __shfl_xor(ss, 1); ss += __shfl_xor(ss, 2); ss += __shfl_xor(ss, 4); ss += __shfl_xor(ss, 8);
            rstd[r] = rsqrtf(ss * (1.0f / 1024.0f) + EPS);
        }
#pragma unroll
        for (int j = 0; j < 4; ++j) {
            const f32x4 gsc = *(const f32x4*)(gpostp + 256 * j) * *(const f32x4*)(gatep + 256 * j);
#pragma unroll
            for (int r = 0; r < NR; ++r) {
                const f32x4 y = {bflo(yb[r][j].x), bfhi(yb[r][j].x), bflo(yb[r][j].y), bfhi(yb[r][j].y)};
                x[r][j] = x[r][j] + gsc * (y * rstd[r]);
            }
        }
    }
    if (a.wr) {
        float* xo0 = (lat ? a.xoutL : a.xoutC) + xrow0 * 1024;
        if (a.xout16) {
#pragma unroll
            for (int r = 0; r < NR; ++r)
#pragma unroll
                for (int j = 0; j < 4; ++j) { u32x2 w; w.x = cvtpk(x[r][j][0], x[r][j][1]); w.y = cvtpk(x[r][j][2], x[r][j][3]);
                    __builtin_nontemporal_store(w, (u32x2*)((bf16_t*)(xo0 + (size_t)r * 1024) + 4 * lane + 256 * j)); }
        } else {
#pragma unroll
            for (int r = 0; r < NR; ++r)
#pragma unroll
                for (int j = 0; j < 4; ++j) __builtin_nontemporal_store(x[r][j], (f32x4*)(xo0 + (size_t)r * 1024 + 4 * lane + 256 * j));
        }
    }
    if (a.nxt) {
        float rstd2[NR];
#pragma unroll
        for (int r = 0; r < NR; ++r) {
            float s2 = 0.f;
#pragma unroll
            for (int j = 0; j < 4; ++j) s2 += (x[r][j][0] * x[r][j][0] + x[r][j][1] * x[r][j][1]) + (x[r][j][2] * x[r][j][2] + x[r][j][3] * x[r][j][3]);
            s2 = wave_sum(s2);
            rstd2[r] = rsqrtf(s2 * (1.0f / 1024.0f) + EPS);
        }
        const float* shp = a.sh + (size_t)bb * 6144 + 4 * lane; const float* scp = a.sc + (size_t)bb * 6144 + 4 * lane; const float* gp = a.gpre + 4 * lane;
        bf16_t* hp = a.H + (size_t)row0 * 1024 + 4 * lane;
#pragma unroll
        for (int j = 0; j < 4; ++j) {
            const f32x4 gm = *(const f32x4*)(gp + 256 * j) * (*(const f32x4*)(scp + 256 * j) + 1.0f), sv = *(const f32x4*)(shp + 256 * j);
#pragma unroll
            for (int r = 0; r < NR; ++r) {
                const f32x4 h = (x[r][j] * rstd2[r]) * gm + sv;
                u32x2 w; w.x = cvtpk(h[0], h[1]); w.y = cvtpk(h[2], h[3]);
                *(u32x2*)(hp + (size_t)r * 1024 + 256 * j) = w;
            }
        }
    }
}
DI void row_phase(const RowArgs& a, int gw, int ngw, int g) {
    int lane = threadIdx.x & 63; asm volatile("" : "+v"(lane));
    for (int rl = gw * 4; rl < a.M; rl += ngw * 4) {
        const int row = g * GROWS + rl;
        row_work<4>(a, row, lane);
    }
}

constexpr int AT_KB = 64 * 144, AT_VB = 64 * 144;
#define MFMA32(a, b, c) __builtin_amdgcn_mfma_f32_32x32x16_bf16((a), (b), (c), 0, 0, 0)
DI float fadd_s(float a, float b) { float r; asm("v_add_f32_e32 %0, %1, %2" : "=v"(r) : "v"(a), "v"(b)); return r; }
DI float swap_max(float m) { auto rr = __builtin_amdgcn_permlane32_swap(__float_as_uint(m), __float_as_uint(m), false, false); return fmaxf(__uint_as_float(rr[0]), __uint_as_float(rr[1])); }
DI float swap_sum(float m) { auto rr = __builtin_amdgcn_permlane32_swap(__float_as_uint(m), __float_as_uint(m), false, false); return __uint_as_float(rr[0]) + __uint_as_float(rr[1]); }
template <bool WINDOW, bool SINK, bool FIXED = false>
DI void attn_unit(LAS unsigned char* lds, const bf16_t* Qp, int qw, const bf16_t* Kb, int kvw, const bf16_t* Vb, bf16_t* Op,
                  int a_lo, int na, int qpos0, float sink2, float ref = 0.f) {
    int tid_ = threadIdx.x; asm volatile("" : "+v"(tid_));
    const int tid = tid_, lane = tid & 63, r32 = lane & 31, hi = lane >> 5; const int wid = __builtin_amdgcn_readfirstlane(tid >> 6);
    bf16x8 qf[4];
    { const bf16_t* qr = Qp + (size_t)(wid * 32 + r32) * qw + 8 * hi;
#pragma unroll
      for (int s = 0; s < 4; ++s) qf[s] = *(const bf16x8*)(qr + 16 * s); }
    constexpr float THR = 8.0f;
    float mhat = FIXED ? 0.f : (SINK ? sink2 : 0.f);
    float lrun = (SINK && hi == 0) ? (FIXED ? __builtin_amdgcn_exp2f(sink2) : 1.f) : 0.f;
    f32x16 o0, o1, negm;
    const f32x16 zero16 = {0.f, 0.f, 0.f, 0.f, 0.f, 0.f, 0.f, 0.f, 0.f, 0.f, 0.f, 0.f, 0.f, 0.f, 0.f, 0.f};
#pragma unroll
    for (int i = 0; i < 16; ++i) { o0[i] = 0.f; o1[i] = 0.f; negm[i] = -mhat; }
    const int srow = tid >> 3, sch = tid & 7;
    const int ntiles = na + 4;
    const int qw0 = qpos0 + wid * 32;
    const int qpos = qw0 + r32;
#define AT_KEY(tt) ((((tt) < na) ? (a_lo + (tt)) : (32 + (tt) - na)) * 64)
#define AT_SKIP(tt) (WINDOW && (tt) < na && (((a_lo + (tt)) * 64 + 63 < qw0 - 128) || ((a_lo + (tt)) * 64 > qw0 + 159)))
#define AT_LDK(key0) (*(const u32x4*)(Kb + (size_t)((key0) + srow) * kvw + sch * 8))
#define AT_LDV(key0) (*(const u32x4*)(Vb + (size_t)srow * KVR + (key0) + sch * 8))
#define AT_STK(buf, reg) (*(LAS u32x4*)(lds + (buf) * AT_KB + srow * 144 + sch * 16) = (reg))
#define AT_STV(buf, reg) (*(LAS u32x4*)(lds + 2 * AT_KB + (buf) * AT_VB + srow * 144 + sch * 16) = (reg))
#define AT_KRD(KL) do { _Pragma("unroll") for (int s_ = 0; s_ < 4; ++s_) { kf[2 * s_] = *(const LAS bf16x8*)((KL) + r32 * 144 + (16 * s_ + 8 * hi) * 2); \
        kf[2 * s_ + 1] = *(const LAS bf16x8*)((KL) + (32 + r32) * 144 + (16 * s_ + 8 * hi) * 2); } __builtin_amdgcn_sched_barrier(0); } while (0)
#define AT_QK(S0, S1, KL, s) do { \
        if ((s) == 0) { if (FIXED) { S0 = MFMA32(kf[0], qf[0], zero16); S1 = MFMA32(kf[1], qf[0], zero16); } else { S0 = MFMA32(kf[0], qf[0], negm); S1 = MFMA32(kf[1], qf[0], negm); } } else { S0 = MFMA32(kf[2 * (s)], qf[s], S0); S1 = MFMA32(kf[2 * (s) + 1], qf[s], S1); } } while (0)
#define AT_SUM(P, sq) do { lacc = fadd_s(fadd_s(fadd_s(fadd_s(lacc, P[8 * (sq) + 0]), P[8 * (sq) + 2]), P[8 * (sq) + 4]), P[8 * (sq) + 6]); lacc2 = fadd_s(fadd_s(fadd_s(fadd_s(lacc2, P[8 * (sq) + 1]), P[8 * (sq) + 3]), P[8 * (sq) + 5]), P[8 * (sq) + 7]); } while (0)
#define AT_VRD(VL) do { _Pragma("unroll") for (int ks_ = 0; ks_ < 4; ++ks_) { const int koff_ = (32 * (ks_ >> 1) + 16 * (ks_ & 1) + 8 * hi) * 2; \
        vf[2 * ks_] = *(const LAS bf16x8*)((VL) + r32 * 144 + koff_); vf[2 * ks_ + 1] = *(const LAS bf16x8*)((VL) + (32 + r32) * 144 + koff_); } __builtin_amdgcn_sched_barrier(0); } while (0)
#define AT_PV(VL, ks, P, sq) do { \
        u32x4 w_; w_.x = cvtpk(P[8 * (sq) + 0], P[8 * (sq) + 1]); w_.y = cvtpk(P[8 * (sq) + 2], P[8 * (sq) + 3]); w_.z = cvtpk(P[8 * (sq) + 4], P[8 * (sq) + 5]); w_.w = cvtpk(P[8 * (sq) + 6], P[8 * (sq) + 7]); \
        const bf16x8 pb_ = __builtin_bit_cast(bf16x8, w_); \
        o0 = MFMA32(vf[2 * (ks)], pb_, o0); o1 = MFMA32(vf[2 * (ks) + 1], pb_, o1); } while (0)
#define AT_EXP8(D, Sx, sq) do { _Pragma("unroll") for (int e_ = 0; e_ < 8; ++e_) D[8 * (sq) + e_] = __builtin_amdgcn_exp2f(Sx[8 * (sq) + e_]); } while (0)
#define AT_MASK(S0, S1, tt) do { \
        if (WINDOW && (tt) < na) { const int k0_ = (a_lo + (tt)) * 64; \
            if (!((k0_ >= qw0 + 31 - 128) && (k0_ + 63 <= qw0 + 128))) { const int x_ = qpos - k0_ - 4 * hi + 128; \
            _Pragma("unroll") for (int i = 0; i < 16; ++i) { const int c_ = (i & 3) + 8 * (i >> 2); \
                if ((unsigned)(x_ - c_) > 256u) S0[i] = -INFINITY; if ((unsigned)(x_ - c_ - 32) > 256u) S1[i] = -INFINITY; } } } } while (0)
#define AT_DECIDE(S0, S1, tt, FORCE) do { \
        if (WINDOW && (tt) < na) { const int k0_ = (a_lo + (tt)) * 64; \
            if (!((k0_ >= qw0 + 31 - 128) && (k0_ + 63 <= qw0 + 128))) { const int x_ = qpos - k0_ - 4 * hi + 128; \
            _Pragma("unroll") for (int i = 0; i < 16; ++i) { const int c_ = (i & 3) + 8 * (i >> 2); \
                if ((unsigned)(x_ - c_) > 256u) S0[i] = -INFINITY; if ((unsigned)(x_ - c_ - 32) > 256u) S1[i] = -INFINITY; } } } \
        float rm_ = fmaxf(S0[0], S1[0]); \
        _Pragma("unroll") for (int i = 1; i < 16; ++i) rm_ = fmaxf(fmaxf(rm_, S0[i]), S1[i]); \
        rm_ = swap_max(rm_); \
        const bool trig_ = (FORCE) || (rm_ > THR); \
        if (__builtin_amdgcn_ballot_w64(trig_) != 0ull) { \
            const float dl_ = (FORCE) ? rm_ : fmaxf(rm_, 0.f); mhat += dl_; \
            _Pragma("unroll") for (int i = 0; i < 16; ++i) { S0[i] -= dl_; S1[i] -= dl_; } \
            _Pragma("unroll") for (int i = 0; i < 16; ++i) negm[i] = -mhat; \
            fsave = __builtin_amdgcn_exp2f(-dl_); lrun *= fsave; resc = true; } } while (0)

    u32x4 kreg, vreg;
    kreg = AT_LDK(AT_KEY(0));
    AT_STK(0, kreg);
    kreg = AT_LDK(AT_KEY(1)); vreg = AT_LDV(AT_KEY(0));
    __syncthreads();
    f32x16 sn0, sn1, pc0, pc1;
    bf16x8 kf[8], vf[8];
    float fsave = 1.f; bool resc = false;
    bool have_cur = !AT_SKIP(0);
    if (have_cur) {
        const LAS unsigned char* Kl = lds;
        AT_KRD(Kl);
        AT_QK(sn0, sn1, Kl, 0); AT_QK(sn0, sn1, Kl, 1); AT_QK(sn0, sn1, Kl, 2); AT_QK(sn0, sn1, Kl, 3);
        if (!FIXED) { AT_DECIDE(sn0, sn1, 0, !SINK); } else { AT_MASK(sn0, sn1, 0); }
        AT_EXP8(pc0, sn0, 0); AT_EXP8(pc0, sn0, 1); AT_EXP8(pc1, sn1, 0); AT_EXP8(pc1, sn1, 1);
        if (resc) {
#pragma unroll
            for (int i = 0; i < 16; ++i) { o0[i] *= fsave; o1[i] *= fsave; }
            resc = false; }
    }
    AT_STK(1, kreg); AT_STV(0, vreg);
    __syncthreads();
#define AT_ITER(t, DD, KLD, VLD, KST, VST, MODE) do { \
        if (t + 2 + DD < ntiles) KLD = AT_LDK(AT_KEY(t + 2 + DD)); \
        if (t + 1 + DD < ntiles) VLD = AT_LDV(AT_KEY(t + 1 + DD)); \
        const bool have_next = ((MODE) == 1) ? true : ((MODE) == 2) ? false : ((t + 1 < ntiles) && !AT_SKIP(t + 1)); \
        const bool hc_ = ((MODE) != 0) ? true : have_cur; \
        const LAS unsigned char* Kl = lds + ((t + 1) & 1) * AT_KB; \
        const LAS unsigned char* Vl = lds + 2 * AT_KB + (t & 1) * AT_VB; \
        float lacc = 0.f, lacc2 = 0.f; \
        if (hc_ && have_next) { \
            AT_KRD(Kl); \
            AT_QK(sn0, sn1, Kl, 0); AT_SUM(pc0, 0); \
            AT_QK(sn0, sn1, Kl, 1); AT_SUM(pc0, 1); \
            AT_QK(sn0, sn1, Kl, 2); AT_SUM(pc1, 0); \
            AT_QK(sn0, sn1, Kl, 3); AT_SUM(pc1, 1); \
            lrun += lacc + lacc2; \
            __builtin_amdgcn_sched_barrier(0); \
            AT_VRD(Vl); \
            if (!FIXED) { AT_DECIDE(sn0, sn1, t + 1, false); } else { AT_MASK(sn0, sn1, t + 1); } \
            AT_PV(Vl, 0, pc0, 0); AT_EXP8(pc0, sn0, 0); \
            AT_PV(Vl, 1, pc0, 1); AT_EXP8(pc0, sn0, 1); \
            AT_PV(Vl, 2, pc1, 0); AT_EXP8(pc1, sn1, 0); \
            AT_PV(Vl, 3, pc1, 1); AT_EXP8(pc1, sn1, 1); \
        } else { \
            if (hc_) { AT_SUM(pc0, 0); AT_SUM(pc0, 1); AT_SUM(pc1, 0); AT_SUM(pc1, 1); lrun += lacc + lacc2; } \
            if (have_next) { AT_KRD(Kl); AT_QK(sn0, sn1, Kl, 0); AT_QK(sn0, sn1, Kl, 1); AT_QK(sn0, sn1, Kl, 2); AT_QK(sn0, sn1, Kl, 3); if (!FIXED) { AT_DECIDE(sn0, sn1, t + 1, false); } else { AT_MASK(sn0, sn1, t + 1); } } \
            if (hc_) { AT_VRD(Vl); AT_PV(Vl, 0, pc0, 0); AT_PV(Vl, 1, pc0, 1); AT_PV(Vl, 2, pc1, 0); AT_PV(Vl, 3, pc1, 1); } \
            if (have_next) { AT_EXP8(pc0, sn0, 0); AT_EXP8(pc0, sn0, 1); AT_EXP8(pc1, sn1, 0); AT_EXP8(pc1, sn1, 1); } \
        } \
        if (resc) { \
            _Pragma("unroll") \
            for (int i = 0; i < 16; ++i) { o0[i] *= fsave; o1[i] *= fsave; } \
            resc = false; } \
        if (t + 2 < ntiles) AT_STK(t & 1, KST); \
        if (t + 1 < ntiles) AT_STV((t + 1) & 1, VST); \
        __syncthreads(); \
        have_cur = have_next; \
    } while (0)
    if constexpr (!WINDOW) {
        u32x4 kreg2, vreg2;
        if (ntiles > 2) kreg2 = AT_LDK(AT_KEY(2));
        vreg2 = AT_LDV(AT_KEY(1));
        for (int t2 = 0; t2 < ntiles - 2; t2 += 2) {
            { const int t = t2; AT_ITER(t, 1, kreg, vreg, kreg2, vreg2, 1); }
            { const int t = t2 + 1; AT_ITER(t, 1, kreg2, vreg2, kreg, vreg, 1); }
        }
        { const int t = ntiles - 2; AT_ITER(t, 1, kreg, vreg, kreg2, vreg2, 1); }
        { const int t = ntiles - 1; AT_ITER(t, 1, kreg2, vreg2, kreg, vreg, 2); }
    } else {
        for (int t = 0; t < ntiles; ++t) { AT_ITER(t, 0, kreg, vreg, kreg, vreg, 0); }
    }
#undef AT_ITER
#undef AT_KEY
#undef AT_SKIP
#undef AT_LDK
#undef AT_LDV
#undef AT_STK
#undef AT_STV
#undef AT_QK
#undef AT_KRD
#undef AT_VRD
#undef AT_SUM
#undef AT_PV
#undef AT_EXP8
#undef AT_DECIDE
#undef AT_MASK
    const float lt = swap_sum(lrun);
    const float inv = 1.0f / lt;
    bf16_t* orow = Op + (size_t)(wid * 32 + r32) * 1024 + 4 * hi;
#pragma unroll
    for (int g = 0; g < 4; ++g) {
        u32x2 w0, w1;
        w0.x = cvtpk(o0[4 * g + 0] * inv, o0[4 * g + 1] * inv); w0.y = cvtpk(o0[4 * g + 2] * inv, o0[4 * g + 3] * inv);
        w1.x = cvtpk(o1[4 * g + 0] * inv, o1[4 * g + 1] * inv); w1.y = cvtpk(o1[4 * g + 2] * inv, o1[4 * g + 3] * inv);
        *(u32x2*)(orow + 8 * g) = w0; *(u32x2*)(orow + 32 + 8 * g) = w1;
    }
}

template <int GI>
DI void pool_unit_t(int rt, const bf16_t* U, const bf16_t* WpT, const float* pscale, bf16_t* MIX) {
    constexpr int g = GI, w = 2 << GI, hw = w >> 1;
    int tid_ = threadIdx.x; asm volatile("" : "+v"(tid_));
    const int tid = tid_, lane = tid & 63, fr = lane & 15, fq = lane >> 4; const int wid = __builtin_amdgcn_readfirstlane(tid >> 6);
    const int row = rt * 128 + wid * 16 + fr;
    const int rlq = row % GROWS;
    const bool lat = rlq < GLAT;
    const int t = lat ? (rlq & (SEQ - 1)) : ((rlq - GLAT) & (CTX - 1));
    const int S = lat ? SEQ : CTX;
    const int base = row - t;
    const int lo = (t - hw) < 0 ? 0 : (t - hw), hi = (t + hw) > S ? S : (t + hw);
    const float icnt = 1.0f / (float)(hi - lo);
    bf16x8 af[4];
#pragma unroll
    for (int ks = 0; ks < 4; ++ks) {
        const int c0 = g * 128 + 32 * ks + 8 * fq;
        u32x4 uv[w];
#pragma unroll
        for (int j = 0; j < w; ++j) {
            const int p = t - hw + j; const bool ok = (p >= 0 && p < S);
            uv[j] = *(const u32x4*)(U + (size_t)(base + (ok ? p : t)) * 512 + c0);
        }
        const u32x4 us = *(const u32x4*)(U + (size_t)row * 512 + c0);
        float sum[8];
#pragma unroll
        for (int e = 0; e < 8; ++e) sum[e] = 0.f;
#pragma unroll
        for (int j = 0; j < w; ++j) {
            const int p = t - hw + j; const float wt = (p >= 0 && p < S) ? 1.0f : 0.0f;
            sum[0] += wt * bflo(uv[j].x); sum[1] += wt * bfhi(uv[j].x); sum[2] += wt * bflo(uv[j].y); sum[3] += wt * bfhi(uv[j].y);
            sum[4] += wt * bflo(uv[j].z); sum[5] += wt * bfhi(uv[j].z); sum[6] += wt * bflo(uv[j].w); sum[7] += wt * bfhi(uv[j].w);
        }
        const float u0 = bflo(us.x), u1 = bfhi(us.x), u2 = bflo(us.y), u3 = bfhi(us.y), u4 = bflo(us.z), u5 = bfhi(us.z), u6 = bflo(us.w), u7 = bfhi(us.w);
        u32x4 d; d.x = cvtpk(sum[0] * icnt - u0, sum[1] * icnt - u1); d.y = cvtpk(sum[2] * icnt - u2, sum[3] * icnt - u3);
        d.z = cvtpk(sum[4] * icnt - u4, sum[5] * icnt - u5); d.w = cvtpk(sum[6] * icnt - u6, sum[7] * icnt - u7);
        af[ks] = __builtin_bit_cast(bf16x8, d);
    }
    const bf16_t* wp = WpT + (size_t)g * 128 * 128;
#pragma unroll
    for (int nt = 0; nt < 8; ++nt) {
        f32x4 acc = {0.f, 0.f, 0.f, 0.f};
#pragma unroll
        for (int ks = 0; ks < 4; ++ks) {
            const bf16x8 bfrag = *(const bf16x8*)(wp + (size_t)(16 * nt + fr) * 128 + 32 * ks + 8 * fq);
            acc = __builtin_amdgcn_mfma_f32_16x16x32_bf16(bfrag, af[ks], acc, 0, 0, 0);
        }
        const int n = g * 128 + 16 * nt + 4 * fq;
        const f32x4 ps = *(const f32x4*)(pscale + n);
        u32x2 w2; w2.x = cvtpk(acc[0] * ps[0], acc[1] * ps[1]); w2.y = cvtpk(acc[2] * ps[2], acc[3] * ps[3]);
        *(u32x2*)(MIX + (size_t)row * 1024 + 512 + n) = w2;
    }
}
DI void pool_unit(int rt, int g, const bf16_t* U, const bf16_t* WpT, const float* pscale, bf16_t* MIX) {
    if (g == 0) pool_unit_t<0>(rt, U, WpT, pscale, MIX);
    else if (g == 1) pool_unit_t<1>(rt, U, WpT, pscale, MIX);
    else if (g == 2) pool_unit_t<2>(rt, U, WpT, pscale, MIX);
    else pool_unit_t<3>(rt, U, WpT, pscale, MIX);
}

#define XB_TMO      128
#define XB_XCNT(j)  (256  + 64 * (j))
#define XB_XSUB(j)  (1280 + 64 * (j))
#define XB_XGEN(j)  (2304 + 64 * (j))
#define XB_TOP      3328
#define XB_TOPGEN   3392
#define XCD_BAR_WORDS 3456
#define XB_SPIN_CAP (1u << 18)
__device__ __forceinline__ unsigned xb_ld(unsigned* p)              { return __hip_atomic_load(p, __ATOMIC_RELAXED, __HIP_MEMORY_SCOPE_AGENT); }
__device__ __forceinline__ unsigned xb_add(unsigned* p, unsigned v) { return __hip_atomic_fetch_add(p, v, __ATOMIC_RELAXED, __HIP_MEMORY_SCOPE_AGENT); }
__device__ __forceinline__ unsigned xb_xcc_id() { return (unsigned)__builtin_amdgcn_s_getreg((3 << 11) | 20) & 0xFu; }
#define XB_SPIN(cond, bar) do { unsigned _sp = 0; while (cond) { __builtin_amdgcn_s_sleep(1); \
    if ((++_sp & 255u) == 0u) { if (xb_ld(&(bar)[XB_TMO])) break; if (_sp > XB_SPIN_CAP) { atomicAdd(&(bar)[XB_TMO], 1u); break; } } } } while (0)
struct XcdBarrier { unsigned* bar; unsigned x; volatile LAS unsigned* st; unsigned gsize; };
__device__ __forceinline__ XcdBarrier xcd_barrier_post(unsigned* bar, volatile LAS unsigned* st, unsigned gsize) {
    XcdBarrier b; b.bar = bar; b.x = xb_xcc_id(); b.st = st; b.gsize = gsize;
    if (threadIdx.x == 0) (void)xb_add(&bar[XB_XCNT(b.x)], 1u);
    return b;
}
__device__ __forceinline__ void xcd_barrier_complete(unsigned* bar, unsigned x, unsigned G, unsigned& nloc, unsigned& nx) {
    unsigned sum, cnt, mine, sp = 0u;
    for (;;) {
        sum = 0u; cnt = 0u; mine = 0u;
#pragma unroll
        for (unsigned j = 0; j < 16; ++j) { const unsigned c = xb_ld(&bar[XB_XCNT(j)]); sum += c; cnt += (c > 0u) ? 1u : 0u; mine = (j == x) ? c : mine; }
        if (sum == G) break;
        __builtin_amdgcn_s_sleep(1);
        if ((++sp & 255u) == 0u) { if (xb_ld(&bar[XB_TMO])) break; if (sp > XB_SPIN_CAP) { atomicAdd(&bar[XB_TMO], 1u); break; } }
    }
    nloc = mine > 0u ? mine : 1u; nx = cnt > 0u ? cnt : 1u;
}
__device__ __forceinline__ void xcd_barrier(const XcdBarrier& b) {
    asm volatile("s_waitcnt vmcnt(0)" ::: "memory");
    __syncthreads();
    if (threadIdx.x == 0) {
        unsigned* bar = b.bar; asm volatile("" : "+s"(bar));
        unsigned bx_ = b.x; asm volatile("" : "+s"(bx_));
        __builtin_amdgcn_s_waitcnt(0);
        unsigned nloc = b.st[0], nx = b.st[1];
        if (nloc == 0u) { xcd_barrier_complete(bar, bx_, b.gsize, nloc, nx); b.st[0] = nloc; b.st[1] = nx; }
        const unsigned old = xb_add(&bar[XB_XSUB(bx_)], 1u);
        const unsigned gen = old / nloc;
        if (old + 1u == (gen + 1u) * nloc) {
            __builtin_amdgcn_fence(__ATOMIC_RELEASE, "agent");
            asm volatile("s_waitcnt vmcnt(0)" ::: "memory");
            const unsigned og = xb_add(&bar[XB_TOP], 1u);
            const unsigned tg = og / nx;
            if (og + 1u == (tg + 1u) * nx) xb_add(&bar[XB_TOPGEN], 1u);
            else XB_SPIN(xb_ld(&bar[XB_TOPGEN]) == tg, bar);
            __builtin_amdgcn_fence(__ATOMIC_ACQUIRE, "agent");
            xb_add(&bar[XB_XGEN(bx_)], 1u);
            asm volatile("s_waitcnt vmcnt(0)" ::: "memory");
        } else {
            XB_SPIN(xb_ld(&bar[XB_XGEN(bx_)]) == gen, bar);
            __builtin_amdgcn_fence(__ATOMIC_ACQUIRE, "agent");
            asm volatile("s_waitcnt vmcnt(0)" ::: "memory");
        }
    }
    __syncthreads();
}

struct Args { const float* in[21]; float* out; unsigned char* ws; int never; int pad; };
constexpr size_t CTL_FLAG = 31744;
constexpr int STAGGER_SPIN = 0;

__global__ void __launch_bounds__(512, 2) fwd_megakernel(Args args) {
    extern __shared__ __attribute__((aligned(16))) unsigned char lds_raw[];
    LAS unsigned char* lds = (LAS unsigned char*)lds_raw;
    cg::grid_group grid = cg::this_grid();
    const int tid = threadIdx.x; const int wave = __builtin_amdgcn_readfirstlane(tid >> 6);
    const int G = gridDim.x, bx = blockIdx.x;
    const int grp = (bx >> 3) & 1, c = ((bx >> 4) << 3) | (bx & 7), Gg = G >> 1;
    volatile LAS unsigned* xst = (volatile LAS unsigned*)(lds + LDS_BYTES - 16);
    if (tid < 4) xst[tid] = 0u;
    __syncthreads();
    XcdBarrier xbar = xcd_barrier_post((unsigned*)args.ws + grp * 4096, xst, (unsigned)Gg);
    XcdBarrier gbar = xcd_barrier_post((unsigned*)args.ws + 2 * 4096, xst + 2, (unsigned)G);
#define GBAR() xcd_barrier(xbar)
    unsigned char* ws = args.ws;
    unsigned* flagw = (unsigned*)(ws + CTL_FLAG);
    const float* x_in = args.in[0]; const float* c_in = args.in[1]; const float* ctx_in = args.in[2]; const float* cctx_in = args.in[3];
    const float* w_mod = args.in[4]; const float* b_mod = args.in[5];
    const float* g_pre_mix = args.in[6]; const float* g_post_mix = args.in[7]; const float* g_pre_ffn = args.in[8]; const float* g_post_ffn = args.in[9];
    const float* we_in = args.in[10]; const float* we_out = args.in[11]; const float* we_qg = args.in[12]; const float* we_kg = args.in[13];
    const float* we_pool = args.in[14]; const float* we_pscale = args.in[15];
    const float* wo_in = args.in[16]; const float* wo_out = args.in[17]; const float* wo_sink = args.in[18];
    const float* w_f1 = args.in[19]; const float* w_f2 = args.in[20];
    float* out = args.out;
    float* MOD = (float*)(ws + WS_MOD); float* PART = (float*)(ws + WS_PART); float* PART2 = (float*)(ws + WS_PART2); bf16_t* Y2 = (bf16_t*)(ws + WS_Y2);
    float* XC = (float*)(ws + WS_XC);
    bf16_t* H = (bf16_t*)(ws + WS_H); bf16_t* Y = (bf16_t*)(ws + WS_Y);
    unsigned char* arena = ws + WS_Q + (size_t)grp * (216 * MiB);
    bf16_t* Ub = (bf16_t*)(arena + 108 * MiB) - (size_t)grp * GROWS * 512; bf16_t* MIX = (bf16_t*)(arena + 144 * MiB) - (size_t)grp * GROWS * 1024;
    bf16_t* ACT = (bf16_t*)arena - (size_t)grp * GROWS * FFN;
    const int gw = c * 8 + wave, ngw = Gg * 8;
    const int xl = c & 7, jl = c >> 3;

    for (int it = bx; it < 4 * 48; it += G) mod_item(it, c_in, cctx_in, w_mod, b_mod, MOD, lds);
    for (int l = 0; l < NLAYER; ++l) prep_layer(l, bx, G, ws, lds, we_in, we_out, we_pool, wo_in, wo_out, w_f1, w_f2);
    if (args.never) grid.sync();
    xcd_barrier(gbar);
    {
        RowArgs a{}; a.xinL = x_in; a.xinC = ctx_in; a.H = H; a.gpre = g_pre_mix; a.sh = MOD; a.sc = MOD + 1024; a.M = 36864; a.upd = 0; a.upd2 = 0; a.wr = 0; a.nxt = 1;
        row_phase(a, gw, ngw, grp);
    }
    GBAR();
    for (int l = 0; l < NLAYER; ++l) {
        const int li = l >> 1; const bool ev = (l & 1) == 0; const bool with_ctx = l < NLAYER - 1;
        const int Mlog = with_ctx ? 36864 : 32768;
        unsigned char* wl = ws + WS_W + (size_t)l * WL_STRIDE;
        float* MODl = MOD + (size_t)l * 33 * 6144;
        bf16_t* Qb = (bf16_t*)arena - (size_t)grp * GROWS * (ev ? 512 : 1024);
        bf16_t* Kb = (bf16_t*)(arena + 72 * MiB) - (size_t)(16 * grp) * KVR * (ev ? 128 : 256);
        bf16_t* Vt = (bf16_t*)(arena + 90 * MiB) - (size_t)(16 * grp) * (ev ? 2 : 4) * 64 * KVR;
        {
            pg8::Gemm g{H, (const bf16_t*)(wl + WL_IN), 36864, ev ? 1280 : 1536, 1024}; pg8::GroupOrder S; S.init(g.M, g.N, Gg, c, grp);
            LAS float* ropel = (LAS float*)(lds + 131072);
            rope_table(ropel); __syncthreads();
            EpiQKV E{ev ? 1 : 0, Qb, Kb, Vt, Ub, we_qg + li * 64, we_kg + li * 64, ropel, ev ? (unsigned*)nullptr : (unsigned*)(ws + 49152) + li * 640};
            pg8::gemm_phase<EpiQKV, pg8::GroupOrder>(lds, g, S, E);
        }
        GBAR();
        if (ev) {
            const int n_dense = 1024, n_ctx = with_ctx ? 128 : 0;
            float bref;
            { const int ln = tid & 63; float gq = fabsf(we_qg[li * 64 + ln]), gk = fabsf(we_kg[li * 64 + ln]);
#pragma unroll
              for (int o = 1; o < 64; o <<= 1) { gq = fmaxf(gq, __shfl_xor(gq, o)); gk = fmaxf(gk, __shfl_xor(gk, o)); }
              bref = __uint_as_float(__builtin_amdgcn_readfirstlane(__float_as_uint(64.0f * C2 * gq * gk * 1.02f + 0.25f))); }
            for (int u = c; u < n_dense + n_ctx; u += Gg) {
                int b, head, qrow0, na;
                if (u < n_dense) { int qb = u & 7; head = (u >> 3) & 7; int bl = u >> 6;
                    if (Gg == 128) { const int i = u >> 7, pr = (i >> 1) * 8 + xl, idx = (i & 1) * 16 + jl; bl = pr >> 1; head = (pr & 1) * 4 + (idx >> 3); qb = idx & 7; }
                    b = 16 * grp + bl; qrow0 = grp * GROWS + bl * SEQ + qb * 256; na = 32; }
                else { const int v = u - n_dense; head = v & 7; b = 16 * grp + (v >> 3); qrow0 = grp * GROWS + GLAT + (v >> 3) * CTX; na = 0; }
                const int kvh = head >> 2;
                if (bref <= 40.0f) attn_unit<false, false, true>(lds, Qb + (size_t)qrow0 * 512 + head * 64, 512, Kb + (size_t)b * KVR * 128 + kvh * 64, 128, Vt + (size_t)(b * 2 + kvh) * 64 * KVR,
                                                              MIX + (size_t)qrow0 * 1024 + head * 64, 0, na, 0, 0.f, bref);
                else attn_unit<false, false, false>(lds, Qb + (size_t)qrow0 * 512 + head * 64, 512, Kb + (size_t)b * KVR * 128 + kvh * 64, 128, Vt + (size_t)(b * 2 + kvh) * 64 * KVR,
                                                    MIX + (size_t)qrow0 * 1024 + head * 64, 0, na, 0, 0.f);
            }
            const int n_rt = Mlog / 128, n_pool = n_rt * 4;
            for (int u = c; u < n_pool; u += Gg) { const int tl = u % n_rt; const int rt = grp * (GROWS / 128) + tl;
                pool_unit(rt, u / n_rt, Ub, (const bf16_t*)(wl + WL_POOL), we_pscale + li * 512, MIX); }
        } else {
            const int n_win = 2048, n_ctx = with_ctx ? 256 : 0;
            for (int u = c; u < n_win + n_ctx; u += Gg) {
                if (u < n_win) {
                    int qb = u & 7, head = (u >> 3) & 15, bl = u >> 7;
                    if (Gg == 128) { const int i = u >> 7, pr = (i >> 1) * 8 + xl, idx = (i & 1) * 16 + jl; bl = pr >> 2; head = (pr & 3) * 4 + (idx >> 3); qb = ((idx & 7) + (i >> 1)) & 7; }
                    const int b = 16 * grp + bl; const int q0 = qb * 256, qrow0 = grp * GROWS + bl * SEQ + q0, kvh = head >> 2;
                    const int klo = (q0 - 128) < 0 ? 0 : (q0 - 128), khi = (q0 + 384) > SEQ ? SEQ : (q0 + 384);
                    const float sk = wo_sink[li * 16 + head] * LOG2E;
                    unsigned* mwp = (unsigned*)(ws + 49152) + li * 640 + b * 20;
                    const float mq2 = __uint_as_float(__builtin_amdgcn_readfirstlane(__hip_atomic_load(mwp + head, __ATOMIC_RELAXED, __HIP_MEMORY_SCOPE_AGENT)));
                    const float mk2 = __uint_as_float(__builtin_amdgcn_readfirstlane(__hip_atomic_load(mwp + 16 + kvh, __ATOMIC_RELAXED, __HIP_MEMORY_SCOPE_AGENT)));
                    const float refw = fmaxf(sqrtf(mq2 * mk2) * 1.02f + 0.25f, sk);
                    if (refw <= 50.0f && sk >= -60.0f)
                        attn_unit<true, true, true>(lds, Qb + (size_t)qrow0 * 1024 + head * 64, 1024, Kb + (size_t)b * KVR * 256 + kvh * 64, 256, Vt + (size_t)(b * 4 + kvh) * 64 * KVR,
                                                    MIX + (size_t)qrow0 * 1024 + head * 64, klo >> 6, (khi - klo) >> 6, q0, sk, refw);
                    else
                    attn_unit<true, true>(lds, Qb + (size_t)qrow0 * 1024 + head * 64, 1024, Kb + (size_t)b * KVR * 256 + kvh * 64, 256, Vt + (size_t)(b * 4 + kvh) * 64 * KVR,
                                          MIX + (size_t)qrow0 * 1024 + head * 64, klo >> 6, (khi - klo) >> 6, q0, sk);
                } else {
                    const int v = u - n_win, head = v & 15, b = 16 * grp + (v >> 4); const int qrow0 = grp * GROWS + GLAT + (v >> 4) * CTX, kvh = head >> 2;
                    const float sk = wo_sink[li * 16 + head] * LOG2E;
                    attn_unit<false, true>(lds, Qb + (size_t)qrow0 * 1024 + head * 64, 1024, Kb + (size_t)b * KVR * 256 + kvh * 64, 256, Vt + (size_t)(b * 4 + kvh) * 64 * KVR,
                                           MIX + (size_t)qrow0 * 1024 + head * 64, 0, 0, 0, sk);
                }
            }
        }
        GBAR();
        {
            pg8::Gemm g{MIX, (const bf16_t*)(wl + WL_OUT), Mlog, 1024, 1024}; pg8::GroupOrder S; S.init(g.M, g.N, Gg, c, grp);
            EpiY E{Y, PART};
            pg8::gemm_phase<EpiY, pg8::GroupOrder>(lds, g, S, E);
        }
        GBAR();
        {
            RowArgs a{}; a.xinL = (l == 0) ? x_in : out; a.xinC = (l == 0) ? ctx_in : XC; a.xoutL = out; a.xoutC = XC;
            a.Y = Y; a.PART = PART; a.gate = MODl + 2048; a.gpost = g_post_mix + l * 1024;
            a.H = H; a.gpre = g_pre_ffn + l * 1024; a.sh = MODl + 3072; a.sc = MODl + 4096; a.M = Mlog; a.upd = 1; a.upd2 = 0; a.wr = 0; a.nxt = 1; a.xin16 = (l > 0) ? 1 : 0;
            row_phase(a, gw, ngw, grp);
        }
        GBAR();
        {
            pg8::Gemm g{H, (const bf16_t*)(wl + WL_F1), Mlog, 2 * FFN, 1024}; pg8::GroupOrder S; S.init(g.M, g.N, Gg, c, grp);
            EpiSwiGLU E{ACT};
            pg8::gemm_phase<EpiSwiGLU, pg8::GroupOrder>(lds, g, S, E);
        }
        GBAR();
        {
            pg8::Gemm g{ACT, (const bf16_t*)(wl + WL_F2), Mlog, 1024, FFN}; pg8::GroupOrder S; S.init(g.M, g.N, Gg, c, grp);
            EpiY E{Y2, PART2};
            pg8::gemm_phase<EpiY, pg8::GroupOrder>(lds, g, S, E);
        }
        GBAR();
        {
            RowArgs a{}; a.xinL = (l == 0) ? x_in : out; a.xinC = (l == 0) ? ctx_in : XC; a.xoutL = out; a.xoutC = XC;
            a.Y = Y; a.PART = PART; a.gate = MODl + 2048; a.gpost = g_post_mix + l * 1024;
            a.Y2 = Y2; a.PART2 = PART2; a.gate2 = MODl + 5120; a.gpost2 = g_post_ffn + l * 1024;
            a.H = H; a.gpre = g_pre_mix + (l + 1 < NLAYER ? l + 1 : l) * 1024; a.sh = MODl + 33 * 6144; a.sc = MODl + 33 * 6144 + 1024; a.M = Mlog; a.upd = 1; a.upd2 = 1; a.wr = 1; a.nxt = with_ctx ? 1 : 0; a.xin16 = (l > 0) ? 1 : 0; a.xout16 = with_ctx ? 1 : 0;
            row_phase(a, gw, ngw, grp);
        }
        if (l + 1 < NLAYER) GBAR();
    }
#undef GBAR
}

extern "C" void kernel_launch(void* const* d_in, const int* in_sizes, int n_in, void* d_out, int out_size, void* d_ws, size_t ws_size, hipStream_t stream) {
    static int grid = 0;
    if (grid == 0) {
        if (n_in != 21 || out_size != NL * DM || ws_size < WS_END) { fprintf(stderr, "kernel_launch: unexpected shapes (n_in %d out %d ws %zu)\n", n_in, out_size, ws_size); grid = -1; return; }
        int dev = 0, cus = 0, per_cu = 0;
        (void)hipGetDevice(&dev);
        (void)hipDeviceGetAttribute(&cus, hipDeviceAttributeMultiprocessorCount, dev);
        if (hipFuncSetAttribute((const void*)fwd_megakernel, hipFuncAttributeMaxDynamicSharedMemorySize, LDS_BYTES) != hipSuccess) { fprintf(stderr, "kernel_launch: hipFuncSetAttribute failed\n"); }
        if (hipOccupancyMaxActiveBlocksPerMultiprocessor(&per_cu, (const void*)fwd_megakernel, 512, LDS_BYTES) != hipSuccess || per_cu < 1) { fprintf(stderr, "kernel_launch: occupancy query says %d\n", per_cu); per_cu = 1; }
        (void)hipGetLastError();
        if (per_cu > 1) per_cu = 1;
        grid = (cus * per_cu) & ~1;
    }
    if (grid < 0) return;
    if (hipMemsetAsync(d_ws, 0, 57344, stream) != hipSuccess) { fprintf(stderr, "kernel_launch: memset of barrier words failed\n"); return; }
    Args a{};
    for (int i = 0; i < 21; ++i) a.in[i] = (const float*)d_in[i];
    a.out = (float*)d_out; a.ws = (unsigned char*)d_ws;
    void* kargs[] = {&a};
    hipError_t e = hipLaunchCooperativeKernel((const void*)fwd_megakernel, dim3(grid), dim3(512), kargs, LDS_BYTES, stream);
    if (e != hipSuccess) fprintf(stderr, "cooperative launch failed: %s (grid %d)\n", hipGetErrorString(e), grid);
}
```

```cpp
#include <hip/hip_runtime.h>
#include <hip/hip_cooperative_groups.h>
#include <cstdio>
#include <cstdint>
namespace cg = cooperative_groups;

#define DI __device__ __forceinline__
#define LAS __attribute__((address_space(3)))
typedef unsigned short bf16_t;
typedef short bf16x8 __attribute__((ext_vector_type(8)));
typedef short s16x4 __attribute__((ext_vector_type(4)));
typedef float f32x4 __attribute__((ext_vector_type(4)));
typedef float f32x16 __attribute__((ext_vector_type(16)));
typedef unsigned u32x4 __attribute__((ext_vector_type(4)));
typedef unsigned u32x2 __attribute__((ext_vector_type(2)));
typedef float f32x2_t __attribute__((ext_vector_type(2)));
typedef __bf16 bf16x2_t __attribute__((ext_vector_type(2)));

DI unsigned cvtpk(float lo, float hi) { f32x2_t v = {lo, hi}; bf16x2_t b = __builtin_convertvector(v, bf16x2_t); return __builtin_bit_cast(unsigned, b); }
DI float bf2f(unsigned short b) { return __uint_as_float(((unsigned)b) << 16); }
DI float bflo(unsigned w) { return __uint_as_float(w << 16); }
DI float bfhi(unsigned w) { return __uint_as_float(w & 0xffff0000u); }

constexpr int DM = 1024, NBATCH = 32, SEQ = 2048, CTX = 256, NLAYER = 4;
constexpr int NL = NBATCH * SEQ;
constexpr int NC = NBATCH * CTX;
constexpr int NT = NL + NC;
constexpr int GROWS = 36864, GLAT = 32768, GPAN = 144;
constexpr int KVR = SEQ + CTX;
constexpr int FFN = 2816;
constexpr float EPS = 1e-6f;
constexpr float LOG2E = 1.4426950408889634f;
constexpr float C2 = 0.125f * LOG2E;

constexpr size_t MiB = 1u << 20;
constexpr size_t WS_MOD = 1 * MiB;
constexpr size_t WS_ROPE = 5 * MiB;
constexpr size_t WS_PART = 6 * MiB;
constexpr size_t WS_PART2 = 11 * MiB;
constexpr size_t WS_W = 16 * MiB;
constexpr size_t WL_IN = 0, WL_OUT = 3 * MiB, WL_POOL = 5 * MiB, WL_F1 = 6 * MiB, WL_F2 = 17 * MiB, WL_STRIDE = 24 * MiB;
constexpr size_t WS_XC = 112 * MiB;
constexpr size_t WS_H = 144 * MiB;
constexpr size_t WS_Y = 288 * MiB;
constexpr size_t WS_Q = 432 * MiB;
constexpr size_t WS_K = 576 * MiB;
constexpr size_t WS_VT = 612 * MiB;
constexpr size_t WS_U = 648 * MiB;
constexpr size_t WS_MIX = 720 * MiB;
constexpr size_t WS_ACT = 432 * MiB;
constexpr size_t WS_Y2 = 864 * MiB;
constexpr size_t WS_END = 1008 * MiB;
constexpr int LDS_BYTES = 147456;

namespace pg8 {
#define PG8_LAS __attribute__((address_space(3)))
constexpr int BM = 256, BK = 64, HALF = 128, HTB = HALF * BK * 2, STAGE_BYTES = 8 * HTB, NXCD = 8, WGM = 4;
__host__ __device__ __forceinline__ int lds_byte(int r, int c) { const int st = (r >> 4) * 2 + (c >> 5), rr = r & 15, cc = c & 31, ob = rr * 64 + cc * 2; return st * 1024 + (ob ^ (((ob >> 9) & 1) << 5)); }
__host__ __device__ __forceinline__ void stage_rc(int b, int& R, int& C) { const int st = b / 1024, sb = b % 1024, swz = sb ^ (((sb >> 9) & 1) << 5); R = (st >> 1) * 16 + swz / 64; C = (st & 1) * 32 + (swz % 64) / 2; }
struct Unit { int pm, pn; };
struct Gemm { const bf16_t* A; const bf16_t* Bt; int M, N, K; };
struct StaticOrder {
    int nM, nN, nwg, G, c;
    __host__ __device__ void init(int M, int N, int G_, int c_) { nM = M / BM; nN = N / BM; nwg = nM * nN; G = G_; c = c_; }
    __host__ __device__ bool next(int i, Unit& u) const {
        const long L = (long)i * G + c; if (L >= nwg) return false;
        int wgid = (int)L; { const int q = nwg / NXCD, r = nwg % NXCD, xcd = wgid % NXCD, off = wgid / NXCD; wgid = (xcd < r ? xcd * (q + 1) : r * (q + 1) + (xcd - r) * q) + off; }
        const int nig = WGM * nN, gid = wgid / nig, fm = gid * WGM, gsz = (nM - fm) < WGM ? (nM - fm) : WGM;
        u.pm = fm + ((wgid % nig) % gsz); u.pn = (wgid % nig) / gsz; return true;
    }
};
struct GroupOrder {
    StaticOrder base; int g;
    __host__ __device__ void init(int Mlog, int N, int Gg, int c, int g_) { base.init(Mlog, N, Gg, c); g = g_; }
    __host__ __device__ bool next(int i, Unit& u) const {
        if (!base.next(i, u)) return false;
        u.pm += 144 * g; return true;
    }
};
template <class Epi, class Sched>
__device__ __forceinline__ void gemm_phase(PG8_LAS unsigned char* lds, const Gemm g, const Sched& S, const Epi& E) {
    int tid_ = threadIdx.x; asm volatile("" : "+v"(tid_));
    const int tid = tid_, wid = __builtin_amdgcn_readfirstlane(tid >> 6), lane = tid & 63, wr = wid >> 2, wc = wid & 3, fr = lane & 15, fq = lane >> 4;
    const int K = g.K, nt = K / BK;
    unsigned voffA[2], voffB[2];
#pragma unroll
    for (int i = 0; i < 2; ++i) { int R, C; stage_rc(tid * 16 + i * 8192, R, C); voffA[i] = (unsigned)(R * K + C) * 2u; voffB[i] = voffA[i]; }
    const size_t kstep = (size_t)(BK * 2);
    const size_t hstep = (size_t)HALF * K * 2;
    const size_t tstep = 2 * hstep;
    const unsigned ldsw = (unsigned)wid * 1024u;
    const int aoff = lds_byte(wr * 64 + fr, fq * 8), boff = lds_byte(wc * 32 + fr, fq * 8);
#define PG8_SA(b, h) (((b) * 2 + (h)) * HTB)
#define PG8_SB(b, h) ((4 + (b) * 2 + (h)) * HTB)
#define PG8_STAGE(bufoff, gbase, voff) do { _Pragma("unroll") for (int _i = 0; _i < 2; ++_i) \
        __builtin_amdgcn_global_load_lds((const unsigned*)((const char*)(gbase) + (voff)[_i]), (PG8_LAS unsigned*)(lds + (bufoff) + ldsw + _i * 8192), 16, 0, 0); } while (0)
#define PG8_LDA(dst, b, h) do { _Pragma("unroll") for (int m = 0; m < 4; ++m) _Pragma("unroll") for (int k = 0; k < 2; ++k) dst[m][k] = *(const PG8_LAS bf16x8*)(lds + PG8_SA(b, h) + aoff + m * 2048 + k * 1024); } while (0)
#define PG8_LDB(dst, b, h) do { _Pragma("unroll") for (int n = 0; n < 2; ++n) _Pragma("unroll") for (int k = 0; k < 2; ++k) dst[n][k] = *(const PG8_LAS bf16x8*)(lds + PG8_SB(b, h) + boff + n * 2048 + k * 1024); } while (0)
#define PG8_MMA(ai, bj, At, Bt) do { __builtin_amdgcn_s_setprio(1); _Pragma("unroll") for (int m = 0; m < 4; ++m) _Pragma("unroll") for (int n = 0; n < 2; ++n) _Pragma("unroll") for (int k = 0; k < 2; ++k) \
        acc[ai][bj][m][n] = __builtin_amdgcn_mfma_f32_16x16x32_bf16(Bt[n][k], At[m][k], acc[ai][bj][m][n], 0, 0, 0); __builtin_amdgcn_s_setprio(0); } while (0)
#define PG8_WAIT_V(n) asm volatile("s_waitcnt vmcnt(" #n ")" ::: "memory")
#define PG8_WAIT_L(n) asm volatile("s_waitcnt lgkmcnt(" #n ")" ::: "memory")
#define PG8_BAR __builtin_amdgcn_s_barrier()
#define PG8_SCHED __builtin_amdgcn_sched_barrier(0)
    Unit cur, nxt; int ui = 0;
    if (!S.next(0, cur)) return;
    f32x4 acc[2][2][4][2];
#pragma unroll
    for (int a = 0; a < 2; ++a)
#pragma unroll
        for (int b = 0; b < 2; ++b)
#pragma unroll
            for (int m = 0; m < 4; ++m)
#pragma unroll
                for (int n = 0; n < 2; ++n) acc[a][b][m][n] = (f32x4){0.f, 0.f, 0.f, 0.f};
    bf16x8 At[4][2], B0[2][2], B1[2][2];
    const char* cA = (const char*)g.A + (size_t)cur.pm * tstep; const char* cB = (const char*)g.Bt + (size_t)cur.pn * tstep;
    PG8_STAGE(PG8_SB(0, 0), cB, voffB); PG8_STAGE(PG8_SB(0, 1), cB + hstep, voffB); PG8_STAGE(PG8_SA(0, 0), cA, voffA); PG8_STAGE(PG8_SA(0, 1), cA + hstep, voffA);
    if (wr == 1) PG8_BAR;
    PG8_WAIT_V(2); PG8_BAR;
    PG8_STAGE(PG8_SB(1, 0), cB + kstep, voffB); PG8_STAGE(PG8_SA(1, 0), cA + kstep, voffA); PG8_STAGE(PG8_SB(1, 1), cB + hstep + kstep, voffB);
    PG8_WAIT_V(6); PG8_BAR;
    for (;;) {
        const bool has_next = S.next(ui + 1, nxt);
        const char* nA = has_next ? (const char*)g.A + (size_t)nxt.pm * tstep : cA; const char* nB = has_next ? (const char*)g.Bt + (size_t)nxt.pn * tstep : cB;
        for (int t = 0; t < nt; t += 2) {
            const bool last = (t == nt - 2);
            const char* a1 = cA + (size_t)(t + 1) * kstep;
            const char* a2 = last ? nA : cA + (size_t)(t + 2) * kstep; const char* b2 = last ? nB : cB + (size_t)(t + 2) * kstep;
            const char* a3 = a2 + kstep; const char* b3 = b2 + kstep;
            PG8_LDB(B0, 0, 0); PG8_LDB(B1, 0, 1); PG8_SCHED; PG8_LDA(At, 0, 0); PG8_STAGE(PG8_SA(1, 1), a1 + hstep, voffA);
            PG8_WAIT_V(8); PG8_WAIT_L(0); PG8_BAR; PG8_MMA(0, 0, At, B0); PG8_MMA(0, 1, At, B1); PG8_BAR; PG8_SCHED;
            PG8_LDA(At, 0, 1); PG8_STAGE(PG8_SB(0, 0), b2, voffB); PG8_STAGE(PG8_SB(0, 1), b2 + hstep, voffB); PG8_STAGE(PG8_SA(0, 0), a2, voffA);
            PG8_WAIT_V(8); PG8_WAIT_L(0); PG8_BAR; PG8_MMA(1, 0, At, B0); PG8_MMA(1, 1, At, B1); PG8_BAR; PG8_SCHED;
            PG8_LDB(B0, 1, 0); PG8_LDB(B1, 1, 1); PG8_SCHED; PG8_LDA(At, 1, 0); PG8_STAGE(PG8_SA(0, 1), a2 + hstep, voffA);
            PG8_WAIT_V(8); PG8_WAIT_L(0); PG8_BAR; PG8_MMA(0, 0, At, B0); PG8_MMA(0, 1, At, B1); PG8_BAR; PG8_SCHED;
            PG8_LDA(At, 1, 1); PG8_STAGE(PG8_SB(1, 0), b3, voffB); PG8_STAGE(PG8_SB(1, 1), b3 + hstep, voffB); PG8_STAGE(PG8_SA(1, 0), a3, voffA);
            PG8_WAIT_V(8); PG8_WAIT_L(0); PG8_BAR; PG8_MMA(1, 0, At, B0); PG8_MMA(1, 1, At, B1); PG8_BAR; PG8_SCHED;
        }
        if (wr == 0) PG8_BAR;
        E(acc, cur, wr, wc, fr, fq);
        if (!has_next) break;
#pragma unroll
        for (int a = 0; a < 2; ++a)
#pragma unroll
            for (int b = 0; b < 2; ++b)
#pragma unroll
                for (int m = 0; m < 4; ++m)
#pragma unroll
                    for (int n = 0; n < 2; ++n) acc[a][b][m][n] = (f32x4){0.f, 0.f, 0.f, 0.f};
        cur = nxt; cA = nA; cB = nB; ++ui;
        if (wr == 1) PG8_BAR;
    }
    PG8_WAIT_V(0);
    PG8_BAR;
#undef PG8_SA
#undef PG8_SB
#undef PG8_STAGE
#undef PG8_LDA
#undef PG8_LDB
#undef PG8_MMA
#undef PG8_WAIT_V
#undef PG8_WAIT_L
#undef PG8_BAR
#undef PG8_SCHED
}
}

struct EpiQKV {
    int even;
    bf16_t* Q; bf16_t* Kb; bf16_t* Vt; bf16_t* U;
    const float* qg; const float* kg; const LAS float* rope; unsigned* maxw;
    DI void operator()(const f32x4 (&acc)[2][2][4][2], const pg8::Unit& u, int wr, int wc, int fr, int fq) const {
        int kind, head;
        const int pn = u.pn;
        if (even) { if (pn < 2) { kind = 0; head = pn * 4 + wc; } else if (pn == 2) { if (wc < 2) { kind = 1; head = wc; } else { kind = 2; head = wc - 2; } } else { kind = 3; head = (pn - 3) * 4 + wc; } }
        else { if (pn < 4) { kind = 0; head = pn * 4 + wc; } else if (pn == 4) { kind = 1; head = wc; } else { kind = 2; head = wc; } }
        const int qw = even ? 512 : 1024, kvw = even ? 128 : 256, nkv = even ? 2 : 4;
        const int gq = u.pm / GPAN, pl = u.pm - gq * GPAN;
        const bool lat = pl < 128;
        int b, pos0;
        if (lat) { b = 16 * gq + (pl >> 3); pos0 = (pl & 7) * 256; } else { b = 16 * gq + (pl - 128); pos0 = SEQ; }
        const int half = fq >> 1, f0 = 8 * (fq & 1);
        const int dbase = 32 * half + f0;
        f32x4 gn[2][2];
        const bool donorm = even && kind <= 1;
        if (donorm) { const float* gp = (kind == 0) ? qg : kg;
#pragma unroll
            for (int bj = 0; bj < 2; ++bj)
#pragma unroll
                for (int n = 0; n < 2; ++n) gn[bj][n] = *(const f32x4*)(gp + dbase + 16 * bj + 4 * n); }
        const float qs = (kind == 0) ? C2 : 1.0f;
        float rmaxn = 0.f;
#pragma unroll
        for (int ai = 0; ai < 2; ++ai)
#pragma unroll
            for (int m = 0; m < 4; ++m) {
                const int rl = 128 * ai + 64 * wr + 16 * m + fr;
                const size_t grow = (size_t)u.pm * 256 + rl;
                const int pos = pos0 + rl;
                f32x4 v[2][2];
#pragma unroll
                for (int bj = 0; bj < 2; ++bj)
#pragma unroll
                    for (int n = 0; n < 2; ++n) v[bj][n] = acc[ai][bj][m][n];
                if (kind <= 1) {
                    if (donorm) {
                        float ss = 0.f;
#pragma unroll
                        for (int bj = 0; bj < 2; ++bj)
#pragma unroll
                            for (int n = 0; n < 2; ++n) ss += (v[bj][n][0] * v[bj][n][0] + v[bj][n][1] * v[bj][n][1]) + (v[bj][n][2] * v[bj][n][2] + v[bj][n][3] * v[bj][n][3]);
                        ss += __shfl_xor(ss, 16); ss += __shfl_xor(ss, 32);
                        const float rstd = rsqrtf(ss * (1.0f / 64.0f) + EPS);
#pragma unroll
                        for (int bj = 0; bj < 2; ++bj)
#pragma unroll
                            for (int n = 0; n < 2; ++n) v[bj][n] = v[bj][n] * rstd * gn[bj][n];
                    }
                    if (lat) {
                        const int p = half ? (pos & 63) : (pos >> 6);
                        const LAS f32x4* rp = (const LAS f32x4*)(rope + (p * 16 + f0) * 2);
#pragma unroll
                        for (int n = 0; n < 2; ++n) {
                            const f32x4 cs0 = rp[2 * n], cs1 = rp[2 * n + 1];
                            const float c[4] = {cs0[0], cs0[2], cs1[0], cs1[2]}, s[4] = {cs0[1], cs0[3], cs1[1], cs1[3]};
#pragma unroll
                            for (int i = 0; i < 4; ++i) { const float a1 = v[0][n][i], a2 = v[1][n][i]; v[0][n][i] = a1 * c[i] - a2 * s[i]; v[1][n][i] = a2 * c[i] + a1 * s[i]; }
                        }
                    }
                    if (maxw) { float nn = 0.f;
#pragma unroll
                        for (int bj = 0; bj < 2; ++bj)
#pragma unroll
                            for (int n = 0; n < 2; ++n) nn += (v[bj][n][0] * v[bj][n][0] + v[bj][n][1] * v[bj][n][1]) + (v[bj][n][2] * v[bj][n][2] + v[bj][n][3] * v[bj][n][3]);
                        nn += __shfl_xor(nn, 16); nn += __shfl_xor(nn, 32); rmaxn = fmaxf(rmaxn, nn * qs * qs); }
                    bf16_t* dst = (kind == 0) ? (Q + grow * qw + head * 64) : (Kb + ((size_t)b * KVR + pos) * kvw + head * 64);
#pragma unroll
                    for (int bj = 0; bj < 2; ++bj) {
                        u32x4 w; w.x = cvtpk(v[bj][0][0] * qs, v[bj][0][1] * qs); w.y = cvtpk(v[bj][0][2] * qs, v[bj][0][3] * qs);
                        w.z = cvtpk(v[bj][1][0] * qs, v[bj][1][1] * qs); w.w = cvtpk(v[bj][1][2] * qs, v[bj][1][3] * qs);
                        *(u32x4*)(dst + dbase + 16 * bj) = w;
                    }
                } else if (kind == 2) {
                    const int posp = (pos & ~15) | (pos & 3) | ((pos & 4) << 1) | ((pos & 8) >> 1);
                    bf16_t* dst = Vt + ((size_t)(b * nkv + head) * 64) * KVR + posp;
#pragma unroll
                    for (int bj = 0; bj < 2; ++bj)
#pragma unroll
                        for (int n = 0; n < 2; ++n)
#pragma unroll
                            for (int i = 0; i < 4; ++i) { const int d = dbase + 16 * bj + 4 * n + i; dst[(size_t)d * KVR] = (bf16_t)(cvtpk(v[bj][n][i], 0.f) & 0xffffu); }
                } else {
                    bf16_t* dst = U + grow * 512 + head * 64;
#pragma unroll
                    for (int bj = 0; bj < 2; ++bj) {
                        u32x4 w; w.x = cvtpk(v[bj][0][0], v[bj][0][1]); w.y = cvtpk(v[bj][0][2], v[bj][0][3]);
                        w.z = cvtpk(v[bj][1][0], v[bj][1][1]); w.w = cvtpk(v[bj][1][2], v[bj][1][3]);
                        *(u32x4*)(dst + dbase + 16 * bj) = w;
                    }
                }
            }
        if (maxw && kind <= 1) {
            rmaxn = fmaxf(rmaxn, __shfl_xor(rmaxn, 1)); rmaxn = fmaxf(rmaxn, __shfl_xor(rmaxn, 2)); rmaxn = fmaxf(rmaxn, __shfl_xor(rmaxn, 4)); rmaxn = fmaxf(rmaxn, __shfl_xor(rmaxn, 8));
            if (fr == 0 && fq == 0) __hip_atomic_fetch_max(maxw + b * 20 + (kind == 0 ? head : 16 + head), __float_as_uint(rmaxn), __ATOMIC_RELAXED, __HIP_MEMORY_SCOPE_AGENT);
        }
    }
};

struct EpiY {
    bf16_t* Y; float* PART;
    DI void operator()(const f32x4 (&acc)[2][2][4][2], const pg8::Unit& u, int wr, int wc, int fr, int fq) const {
#pragma unroll
        for (int ai = 0; ai < 2; ++ai)
#pragma unroll
            for (int m = 0; m < 4; ++m) {
                const size_t row = (size_t)u.pm * 256 + 128 * ai + 64 * wr + 16 * m + fr;
                float ss = 0.f;
#pragma unroll
                for (int bj = 0; bj < 2; ++bj) {
                    const f32x4 v0 = acc[ai][bj][m][0], v1 = acc[ai][bj][m][1];
                    ss += (v0[0] * v0[0] + v0[1] * v0[1]) + (v0[2] * v0[2] + v0[3] * v0[3]) + (v1[0] * v1[0] + v1[1] * v1[1]) + (v1[2] * v1[2] + v1[3] * v1[3]);
                    u32x4 w; w.x = cvtpk(v0[0], v0[1]); w.y = cvtpk(v0[2], v0[3]); w.z = cvtpk(v1[0], v1[1]); w.w = cvtpk(v1[2], v1[3]);
                    *(u32x4*)(Y + row * 1024 + u.pn * 256 + 128 * bj + 32 * wc + 8 * fq) = w;
                }
                ss += __shfl_xor(ss, 16); ss += __shfl_xor(ss, 32);
                if (fq == 0) PART[row * 16 + u.pn * 4 + wc] = ss;
            }
    }
};

struct EpiSwiGLU {
    bf16_t* ACT;
    DI void operator()(const f32x4 (&acc)[2][2][4][2], const pg8::Unit& u, int wr, int wc, int fr, int fq) const {
#pragma unroll
        for (int ai = 0; ai < 2; ++ai)
#pragma unroll
            for (int m = 0; m < 4; ++m) {
                const size_t row = (size_t)u.pm * 256 + 128 * ai + 64 * wr + 16 * m + fr;
                float o[2][4];
#pragma unroll
                for (int n = 0; n < 2; ++n)
#pragma unroll
                    for (int i = 0; i < 4; ++i) { const float gt = acc[ai][0][m][n][i], up = acc[ai][1][m][n][i]; o[n][i] = gt * up * __builtin_amdgcn_rcpf(1.0f + __builtin_amdgcn_exp2f(-LOG2E * gt)); }
                u32x4 w; w.x = cvtpk(o[0][0], o[0][1]); w.y = cvtpk(o[0][2], o[0][3]); w.z = cvtpk(o[1][0], o[1][1]); w.w = cvtpk(o[1][2], o[1][3]);
                *(u32x4*)(ACT + row * FFN + u.pn * 128 + 32 * wc + 8 * fq) = w;
            }
    }
};

DI int newrow(int type, int o) {
    if (type == 0) { const int ol = o & 255, bj = ol >> 7, wc = (ol >> 5) & 3, fq = (ol >> 3) & 3, n = (ol >> 2) & 1, i = ol & 3; return (o & ~255) + 128 * bj + 32 * wc + 16 * n + 4 * fq + i; }
    if (type == 1) { const int ol = o & 255, wc = ol >> 6, d = ol & 63, fq = 2 * (d >> 5) + ((d >> 3) & 1), bj = (d >> 4) & 1, n = (d >> 2) & 1, i = d & 3; return (o & ~255) + 128 * bj + 32 * wc + 16 * n + 4 * fq + i; }
    if (type == 2) { const int isu = o >= FFN ? 1 : 0, j = o - FFN * isu, pn = j >> 7, jj = j & 127, wc = jj >> 5, fq = (jj >> 3) & 3, n = (jj >> 2) & 1, i = jj & 3; return pn * 256 + 128 * isu + 32 * wc + 16 * n + 4 * fq + i; }
    return o;
}
DI void prep_item(const float* W, int K, int N, bf16_t* WT, int type, int item, LAS float* scr) {
    int tid_ = threadIdx.x; asm volatile("" : "+v"(tid_)); const int tid = tid_;
    const int nblk = N / 64, kb = item / nblk, nb = item % nblk, k0 = 64 * kb, n0 = 64 * nb;
    { const int r = tid >> 4, c4 = (tid & 15) * 4;
#pragma unroll
      for (int p = 0; p < 2; ++p) { const int kk = r + 32 * p; const f32x4 v = *(const f32x4*)(W + (size_t)(k0 + kk) * N + n0 + c4);
          scr[kk * 65 + c4 + 0] = v[0]; scr[kk * 65 + c4 + 1] = v[1]; scr[kk * 65 + c4 + 2] = v[2]; scr[kk * 65 + c4 + 3] = v[3]; } }
    __syncthreads();
    { const int n = tid >> 3, kc = (tid & 7) * 8; const LAS float* s = scr + kc * 65 + n;
      u32x4 o; o.x = cvtpk(s[0 * 65], s[1 * 65]); o.y = cvtpk(s[2 * 65], s[3 * 65]); o.z = cvtpk(s[4 * 65], s[5 * 65]); o.w = cvtpk(s[6 * 65], s[7 * 65]);
      *(u32x4*)(WT + (size_t)newrow(type, n0 + n) * K + k0 + kc) = o; }
    __syncthreads();
}

DI void prep_layer(int l, int worker, int nworkers, unsigned char* ws, LAS unsigned char* lds, const float* we_in, const float* we_out, const float* we_pool,
                   const float* wo_in, const float* wo_out, const float* w_f1, const float* w_f2) {
    constexpr int I_IN = 384, I_OUT = 256, I_POOL = 16, I_F1 = 1408, I_F2 = 704, I_LAYER = I_IN + I_OUT + I_POOL + I_F1 + I_F2;
    const int li = l >> 1; const bool ev = (l & 1) == 0;
    unsigned char* wl = ws + WS_W + (size_t)l * WL_STRIDE;
    LAS float* scr = (LAS float*)lds;
    for (int it = worker; it < I_LAYER; it += nworkers) {
        int r = it;
        if (r < I_IN) { if (ev) { if (r < 320) prep_item(we_in + (size_t)li * 1024 * 1280, 1024, 1280, (bf16_t*)(wl + WL_IN), 1, r, scr); }
                        else prep_item(wo_in + (size_t)li * 1024 * 1536, 1024, 1536, (bf16_t*)(wl + WL_IN), 1, r, scr); continue; } r -= I_IN;
        if (r < I_OUT) { prep_item((ev ? we_out : wo_out) + (size_t)li * 1024 * 1024, 1024, 1024, (bf16_t*)(wl + WL_OUT), 0, r, scr); continue; } r -= I_OUT;
        if (r < I_POOL) { if (ev) { const int gq = r >> 2; prep_item(we_pool + ((size_t)li * 4 + gq) * 128 * 128, 128, 128, (bf16_t*)(wl + WL_POOL) + (size_t)gq * 128 * 128, 3, r & 3, scr); } continue; } r -= I_POOL;
        if (r < I_F1) { prep_item(w_f1 + (size_t)l * 1024 * 5632, 1024, 5632, (bf16_t*)(wl + WL_F1), 2, r, scr); continue; } r -= I_F1;
        prep_item(w_f2 + (size_t)l * FFN * 1024, FFN, 1024, (bf16_t*)(wl + WL_F2), 0, r, scr);
    }
}

DI void mod_item(int item, const float* c, const float* cctx, const float* w_mod, const float* b_mod, float* MOD, LAS unsigned char* lds) {
    const int tid = threadIdx.x;
    const int l = item / 48, n0 = (item % 48) * 128;
    LAS float* S = (LAS float*)lds;
    for (int idx = tid; idx < 33 * 1024; idx += 512) { const int b = idx >> 10, k = idx & 1023; const float cv = (b < 32) ? c[b * 1024 + k] : cctx[k]; S[idx] = cv / (1.0f + __expf(-cv)); }
    __syncthreads();
    const int lane = tid & 63, kq = tid >> 6;
    float acc0[33], acc1[33];
#pragma unroll
    for (int b = 0; b < 33; ++b) { acc0[b] = 0.f; acc1[b] = 0.f; }
    const float* W = w_mod + (size_t)l * 1024 * 6144 + n0 + lane;
#pragma unroll 2
    for (int k = kq * 128; k < kq * 128 + 128; k += 4) {
        float wa[4], wb[4];
#pragma unroll
        for (int i = 0; i < 4; ++i) { wa[i] = __builtin_nontemporal_load(W + (size_t)(k + i) * 6144); wb[i] = __builtin_nontemporal_load(W + (size_t)(k + i) * 6144 + 64); }
#pragma unroll
        for (int b = 0; b < 33; ++b) { const f32x4 sv = *(const LAS f32x4*)(S + b * 1024 + k);
            acc0[b] += (sv[0] * wa[0] + sv[1] * wa[1]) + (sv[2] * wa[2] + sv[3] * wa[3]);
            acc1[b] += (sv[0] * wb[0] + sv[1] * wb[1]) + (sv[2] * wb[2] + sv[3] * wb[3]); }
    }
    __syncthreads();
    LAS float* red = (LAS float*)lds;
#pragma unroll
    for (int b = 0; b < 33; ++b) { red[(kq * 33 + b) * 128 + lane] = acc0[b]; red[(kq * 33 + b) * 128 + 64 + lane] = acc1[b]; }
    __syncthreads();
    for (int idx = tid; idx < 33 * 128; idx += 512) { const int b = idx >> 7, cc = idx & 127;
        float v = 0.f;
#pragma unroll
        for (int q = 0; q < 8; ++q) v += red[(q * 33 + b) * 128 + cc];
        MOD[((size_t)l * 33 + b) * 6144 + n0 + cc] = v + b_mod[l * 6144 + n0 + cc]; }
    __syncthreads();
}

DI void rope_table(LAS float* rope) {
    for (int idx = threadIdx.x; idx < 1024; idx += 512) {
        const int pos = idx >> 4, f = idx & 15;
        double fr = 1.0; const double q = 0.56234132519034908;
        for (int i = 0; i < f; ++i) fr *= q;
        const float ang = (float)pos * (float)fr;
        double r = (double)ang; const double twopi = 6.283185307179586476925;
        const double kk = __builtin_rint(r * (1.0 / twopi)); r -= kk * twopi;
        const double r2 = r * r; double s = r, ts = r, cc = 1.0, tc = 1.0;
#pragma unroll
        for (int n = 1; n <= 14; ++n) { ts *= r2 * (-1.0 / (double)((2 * n) * (2 * n + 1))); s += ts; tc *= r2 * (-1.0 / (double)((2 * n - 1) * (2 * n))); cc += tc; }
        rope[idx * 2] = (float)cc; rope[idx * 2 + 1] = (float)s;
    }
}

DI float wave_sum(float v) {
#pragma unroll
    for (int o = 1; o < 64; o <<= 1) v += __shfl_xor(v, o);
    return v;
}
struct RowArgs {
    const float* xinL; const float* xinC; float* xoutL; float* xoutC;
    const bf16_t* Y; const float* PART; const float* gate; const float* gpost;
    const bf16_t* Y2; const float* PART2; const float* gate2; const float* gpost2;
    bf16_t* H; const float* gpre; const float* sh; const float* sc;
    int M; int upd; int upd2; int wr; int nxt; int xin16; int xout16;
};
template <int NR>
DI void row_work(const RowArgs& a, int row0, int lane) {
    const int gq = row0 / GROWS, rl0 = row0 - gq * GROWS; const bool lat = rl0 < GLAT;
    const int bb = lat ? (16 * gq + (rl0 >> 11)) : 32;
    const size_t xrow0 = lat ? (size_t)(gq * GLAT + rl0) : (size_t)(gq * 4096 + rl0 - GLAT);
    const float* xi0 = (lat ? a.xinL : a.xinC) + xrow0 * 1024;
    f32x4 x[NR][4];
    if (a.xin16) {
#pragma unroll
        for (int r = 0; r < NR; ++r)
#pragma unroll
            for (int j = 0; j < 4; ++j) { const u32x2 xb = __builtin_nontemporal_load((const u32x2*)((const bf16_t*)(xi0 + (size_t)r * 1024) + 4 * lane + 256 * j));
                x[r][j] = (f32x4){bflo(xb.x), bfhi(xb.x), bflo(xb.y), bfhi(xb.y)}; }
    } else {
#pragma unroll
        for (int r = 0; r < NR; ++r)
#pragma unroll
            for (int j = 0; j < 4; ++j) x[r][j] = __builtin_nontemporal_load((const f32x4*)(xi0 + (size_t)r * 1024 + 4 * lane + 256 * j));
    }
#pragma unroll
    for (int br = 0; br < 2; ++br) {
        if (br == 0 ? !a.upd : !a.upd2) continue;
        const bf16_t* Yp = (br == 0 ? a.Y : a.Y2) + (size_t)row0 * 1024 + 4 * lane; const float* Pp = (br == 0 ? a.PART : a.PART2) + (size_t)row0 * 16 + (lane & 15);
        const float* gatep = (br == 0 ? a.gate : a.gate2) + (size_t)bb * 6144 + 4 * lane; const float* gpostp = (br == 0 ? a.gpost : a.gpost2) + 4 * lane;
        u32x2 yb[NR][4]; float ps[NR];
#pragma unroll
        for (int r = 0; r < NR; ++r) {
#pragma unroll
            for (int j = 0; j < 4; ++j) yb[r][j] = __builtin_nontemporal_load((const u32x2*)(Yp + (size_t)r * 1024 + 256 * j));
            ps[r] = Pp[r * 16];
        }
        float rstd[NR];
#pragma unroll
        for (int r = 0; r < NR; ++r) {
            float ss = ps[r]; ss += __shfl_xor(ss, 1); ss += __shfl_xor(ss, 2); ss += __shfl_xor(ss, 4); ss += __shfl_xor(ss, 8);
            rstd[r] = rsqrtf(ss * (1.0f / 1024.0f) + EPS);
        }
#pragma unroll
        for (int j = 0; j < 4; ++j) {
            const f32x4 gsc = *(const f32x4*)(gpostp + 256 * j) * *(const f32x4*)(gatep + 256 * j);
#pragma unroll
            for (int r = 0; r < NR; ++r) {
                const f32x4 y = {bflo(yb[r][j].x), bfhi(yb[r][j].x), bflo(yb[r][j].y), bfhi(yb[r][j].y)};
                x[r][j] = x[r][j] + gsc * (y * rstd[r]);
            }
        }
    }
    if (a.wr) {
        float* xo0 = (lat ? a.xoutL : a.xoutC) + xrow0 * 1024;
        if (a.xout16) {
#pragma unroll
            for (int r = 0; r < NR; ++r)
#pragma unroll
                for (int j = 0; j < 4; ++j) { u32x2 w; w.x = cvtpk(x[r][j][0], x[r][j][1]); w.y = cvtpk(x[r][j][2], x[r][j][3]);
                    __builtin_nontemporal_store(w, (u32x2*)((bf16_t*)(xo0 + (size_t)r * 1024) + 4 * lane + 256 * j)); }
        } else {
#pragma unroll
            for (int r = 0; r < NR; ++r)
#pragma unroll
                for (int j = 0; j < 4; ++j) __builtin_nontemporal_store(x[r][j], (f32x4*)(xo0 + (size_t)r * 1024 + 4 * lane + 256 * j));
        }
    }
    if (a.nxt) {
        float rstd2[NR];
#pragma unroll
        for (int r = 0; r < NR; ++r) {
            float s2 = 0.f;
#pragma unroll
            for (int j = 0; j < 4; ++j) s2 += (x[r][j][0] * x[r][j][0] + x[r][j][1] * x[r][j][1]) + (x[r][j][2] * x[r][j][2] + x[r][j][3] * x[r][j][3]);
            s2 = wave_sum(s2);
            rstd2[r] = rsqrtf(s2 * (1.0f / 1024.0f) + EPS);
        }
        const float* shp = a.sh + (size_t)bb * 6144 + 4 * lane; const float* scp = a.sc + (size_t)bb * 6144 + 4 * lane; const float* gp = a.gpre + 4 * lane;
        bf16_t* hp = a.H + (size_t)row0 * 1024 + 4 * lane;
#pragma unroll
        for (int j = 0; j < 4; ++j) {
            const f32x4 gm = *(const f32x4*)(gp + 256 * j) * (*(const f32x4*)(scp + 256 * j) + 1.0f), sv = *(const f32x4*)(shp + 256 * j);
#pragma unroll
            for (int r = 0; r < NR; ++r) {
                const f32x4 h = (x[r][j] * rstd2[r]) * gm + sv;
                u32x2 w; w.x = cvtpk(h[0], h[1]); w.y = cvtpk(h[2], h[3]);
                *(u32x2*)(hp + (size_t)r * 1024 + 256 * j) = w;
            }
        }
    }
}
DI void row_phase(const RowArgs& a, int gw, int ngw, int g) {
    int lane = threadIdx.x & 63; asm volatile("" : "+v"(lane));
    for (int rl = gw * 4; rl < a.M; rl += ngw * 4) {
        const int row = g * GROWS + rl;
        row_work<4>(a, row, lane);
    }
}

constexpr int AT_KB = 64 * 144, AT_VB = 64 * 144;
#define MFMA32(a, b, c) __builtin_amdgcn_mfma_f32_32x32x16_bf16((a), (b), (c), 0, 0, 0)
DI float fadd_s(float a, float b) { float r; asm("v_add_f32_e32 %0, %1, %2" : "=v"(r) : "v"(a), "v"(b)); return r; }
DI float swap_max(float m) { auto rr = __builtin_amdgcn_permlane32_swap(__float_as_uint(m), __float_as_uint(m), false, false); return fmaxf(__uint_as_float(rr[0]), __uint_as_float(rr[1])); }
DI float swap_sum(float m) { auto rr = __builtin_amdgcn_permlane32_swap(__float_as_uint(m), __float_as_uint(m), false, false); return __uint_as_float(rr[0]) + __uint_as_float(rr[1]); }
template <bool WINDOW, bool SINK, bool FIXED = false>
DI void attn_unit(LAS unsigned char* lds, const bf16_t* Qp, int qw, const bf16_t* Kb, int kvw, const bf16_t* Vb, bf16_t* Op,
                  int a_lo, int na, int qpos0, float sink2, float ref = 0.f) {
    int tid_ = threadIdx.x; asm volatile("" : "+v"(tid_));
    const int tid = tid_, lane = tid & 63, r32 = lane & 31, hi = lane >> 5; const int wid = __builtin_amdgcn_readfirstlane(tid >> 6);
    bf16x8 qf[4];
    { const bf16_t* qr = Qp + (size_t)(wid * 32 + r32) * qw + 8 * hi;
#pragma unroll
      for (int s = 0; s < 4; ++s) qf[s] = *(const bf16x8*)(qr + 16 * s); }
    constexpr float THR = 8.0f;
    float mhat = FIXED ? 0.f : (SINK ? sink2 : 0.f);
    float lrun = (SINK && hi == 0) ? (FIXED ? __builtin_amdgcn_exp2f(sink2) : 1.f) : 0.f;
    f32x16 o0, o1, negm;
    const f32x16 zero16 = {0.f, 0.f, 0.f, 0.f, 0.f, 0.f, 0.f, 0.f, 0.f, 0.f, 0.f, 0.f, 0.f, 0.f, 0.f, 0.f};
#pragma unroll
    for (int i = 0; i < 16; ++i) { o0[i] = 0.f; o1[i] = 0.f; negm[i] = -mhat; }
    const int srow = tid >> 3, sch = tid & 7;
    const int ntiles = na + 4;
    const int qw0 = qpos0 + wid * 32;
    const int qpos = qw0 + r32;
#define AT_KEY(tt) ((((tt) < na) ? (a_lo + (tt)) : (32 + (tt) - na)) * 64)
#define AT_SKIP(tt) (WINDOW && (tt) < na && (((a_lo + (tt)) * 64 + 63 < qw0 - 128) || ((a_lo + (tt)) * 64 > qw0 + 159)))
#define AT_LDK(key0) (*(const u32x4*)(Kb + (size_t)((key0) + srow) * kvw + sch * 8))
#define AT_LDV(key0) (*(const u32x4*)(Vb + (size_t)srow * KVR + (key0) + sch * 8))
#define AT_STK(buf, reg) (*(LAS u32x4*)(lds + (buf) * AT_KB + srow * 144 + sch * 16) = (reg))
#define AT_STV(buf, reg) (*(LAS u32x4*)(lds + 2 * AT_KB + (buf) * AT_VB + srow * 144 + sch * 16) = (reg))
#define AT_KRD(KL) do { _Pragma("unroll") for (int s_ = 0; s_ < 4; ++s_) { kf[2 * s_] = *(const LAS bf16x8*)((KL) + r32 * 144 + (16 * s_ + 8 * hi) * 2); \
        kf[2 * s_ + 1] = *(const LAS bf16x8*)((KL) + (32 + r32) * 144 + (16 * s_ + 8 * hi) * 2); } if (!FIXED) __builtin_amdgcn_sched_barrier(0); } while (0)
#define AT_QK(S0, S1, KL, s) do { \
        if ((s) == 0) { if (FIXED) { S0 = MFMA32(kf[0], qf[0], zero16); S1 = MFMA32(kf[1], qf[0], zero16); } else { S0 = MFMA32(kf[0], qf[0], negm); S1 = MFMA32(kf[1], qf[0], negm); } } else { S0 = MFMA32(kf[2 * (s)], qf[s], S0); S1 = MFMA32(kf[2 * (s) + 1], qf[s], S1); } } while (0)
#define AT_SUM(P, sq) do { lacc = fadd_s(fadd_s(fadd_s(fadd_s(lacc, P[8 * (sq) + 0]), P[8 * (sq) + 2]), P[8 * (sq) + 4]), P[8 * (sq) + 6]); lacc2 = fadd_s(fadd_s(fadd_s(fadd_s(lacc2, P[8 * (sq) + 1]), P[8 * (sq) + 3]), P[8 * (sq) + 5]), P[8 * (sq) + 7]); } while (0)
#define AT_VRD(VL) do { _Pragma("unroll") for (int ks_ = 0; ks_ < 4; ++ks_) { const int koff_ = (32 * (ks_ >> 1) + 16 * (ks_ & 1) + 8 * hi) * 2; \
        vf[2 * ks_] = *(const LAS bf16x8*)((VL) + r32 * 144 + koff_); vf[2 * ks_ + 1] = *(const LAS bf16x8*)((VL) + (32 + r32) * 144 + koff_); } if (!FIXED) __builtin_amdgcn_sched_barrier(0); } while (0)
#define AT_PV(VL, ks, P, sq) do { \
        u32x4 w_; w_.x = cvtpk(P[8 * (sq) + 0], P[8 * (sq) + 1]); w_.y = cvtpk(P[8 * (sq) + 2], P[8 * (sq) + 3]); w_.z = cvtpk(P[8 * (sq) + 4], P[8 * (sq) + 5]); w_.w = cvtpk(P[8 * (sq) + 6], P[8 * (sq) + 7]); \
        const bf16x8 pb_ = __builtin_bit_cast(bf16x8, w_); \
        o0 = MFMA32(vf[2 * (ks)], pb_, o0); o1 = MFMA32(vf[2 * (ks) + 1], pb_, o1); } while (0)
#define AT_EXP8(D, Sx, sq) do { _Pragma("unroll") for (int e_ = 0; e_ < 8; ++e_) D[8 * (sq) + e_] = __builtin_amdgcn_exp2f(Sx[8 * (sq) + e_]); } while (0)
#define AT_MASK(S0, S1, tt) do { \
        if (WINDOW && (tt) < na) { const int k0_ = (a_lo + (tt)) * 64; \
            if (!((k0_ >= qw0 + 31 - 128) && (k0_ + 63 <= qw0 + 128))) { const int x_ = qpos - k0_ - 4 * hi + 128; \
            _Pragma("unroll") for (int i = 0; i < 16; ++i) { const int c_ = (i & 3) + 8 * (i >> 2); \
                if ((unsigned)(x_ - c_) > 256u) S0[i] = -INFINITY; if ((unsigned)(x_ - c_ - 32) > 256u) S1[i] = -INFINITY; } } } } while (0)
#define AT_DECIDE(S0, S1, tt, FORCE) do { \
        if (WINDOW && (tt) < na) { const int k0_ = (a_lo + (tt)) * 64; \
            if (!((k0_ >= qw0 + 31 - 128) && (k0_ + 63 <= qw0 + 128))) { const int x_ = qpos - k0_ - 4 * hi + 128; \
            _Pragma("unroll") for (int i = 0; i < 16; ++i) { const int c_ = (i & 3) + 8 * (i >> 2); \
                if ((unsigned)(x_ - c_) > 256u) S0[i] = -INFINITY; if ((unsigned)(x_ - c_ - 32) > 256u) S1[i] = -INFINITY; } } } \
        float rm_ = fmaxf(S0[0], S1[0]); \
        _Pragma("unroll") for (int i = 1; i < 16; ++i) rm_ = fmaxf(fmaxf(rm_, S0[i]), S1[i]); \
        rm_ = swap_max(rm_); \
        const bool trig_ = (FORCE) || (rm_ > THR); \
        if (__builtin_amdgcn_ballot_w64(trig_) != 0ull) { \
            const float dl_ = (FORCE) ? rm_ : fmaxf(rm_, 0.f); mhat += dl_; \
            _Pragma("unroll") for (int i = 0; i < 16; ++i) { S0[i] -= dl_; S1[i] -= dl_; } \
            _Pragma("unroll") for (int i = 0; i < 16; ++i) negm[i] = -mhat; \
            fsave = __builtin_amdgcn_exp2f(-dl_); lrun *= fsave; resc = true; } } while (0)

    u32x4 kreg, vreg;
    kreg = AT_LDK(AT_KEY(0));
    AT_STK(0, kreg);
    kreg = AT_LDK(AT_KEY(1)); vreg = AT_LDV(AT_KEY(0));
    __syncthreads();
    f32x16 sn0, sn1, pc0, pc1;
    bf16x8 kf[8], vf[8];
    float fsave = 1.f; bool resc = false;
    bool have_cur = !AT_SKIP(0);
    if (have_cur) {
        const LAS unsigned char* Kl = lds;
        AT_KRD(Kl);
        AT_QK(sn0, sn1, Kl, 0); AT_QK(sn0, sn1, Kl, 1); AT_QK(sn0, sn1, Kl, 2); AT_QK(sn0, sn1, Kl, 3);
        if (!FIXED) { AT_DECIDE(sn0, sn1, 0, !SINK); } else { AT_MASK(sn0, sn1, 0); }
        AT_EXP8(pc0, sn0, 0); AT_EXP8(pc0, sn0, 1); AT_EXP8(pc1, sn1, 0); AT_EXP8(pc1, sn1, 1);
        if (resc) {
#pragma unroll
            for (int i = 0; i < 16; ++i) { o0[i] *= fsave; o1[i] *= fsave; }
            resc = false; }
    }
    AT_STK(1, kreg); AT_STV(0, vreg);
    __syncthreads();
#define AT_ITER(t, DD, KLD, VLD, KST, VST, MODE) do { \
        if (t + 2 + DD < ntiles) KLD = AT_LDK(AT_KEY(t + 2 + DD)); \
        if (t + 1 + DD < ntiles) VLD = AT_LDV(AT_KEY(t + 1 + DD)); \
        const bool have_next = ((MODE) == 1) ? true : ((MODE) == 2) ? false : ((t + 1 < ntiles) && !AT_SKIP(t + 1)); \
        const bool hc_ = ((MODE) != 0) ? true : have_cur; \
        const LAS unsigned char* Kl = lds + ((t + 1) & 1) * AT_KB; \
        const LAS unsigned char* Vl = lds + 2 * AT_KB + (t & 1) * AT_VB; \
        float lacc = 0.f, lacc2 = 0.f; \
        if (hc_ && have_next) { \
            AT_KRD(Kl); \
            AT_QK(sn0, sn1, Kl, 0); AT_SUM(pc0, 0); \
            AT_QK(sn0, sn1, Kl, 1); AT_SUM(pc0, 1); \
            AT_QK(sn0, sn1, Kl, 2); AT_SUM(pc1, 0); \
            AT_QK(sn0, sn1, Kl, 3); AT_SUM(pc1, 1); \
            lrun += lacc + lacc2; \
            if (!FIXED) __builtin_amdgcn_sched_barrier(0); \
            AT_VRD(Vl); \
            if (!FIXED) { AT_DECIDE(sn0, sn1, t + 1, false); } else { AT_MASK(sn0, sn1, t + 1); } \
            AT_PV(Vl, 0, pc0, 0); AT_EXP8(pc0, sn0, 0); \
            AT_PV(Vl, 1, pc0, 1); AT_EXP8(pc0, sn0, 1); \
            AT_PV(Vl, 2, pc1, 0); AT_EXP8(pc1, sn1, 0); \
            AT_PV(Vl, 3, pc1, 1); AT_EXP8(pc1, sn1, 1); \
        } else { \
            if (hc_) { AT_SUM(pc0, 0); AT_SUM(pc0, 1); AT_SUM(pc1, 0); AT_SUM(pc1, 1); lrun += lacc + lacc2; } \
            if (have_next) { AT_KRD(Kl); AT_QK(sn0, sn1, Kl, 0); AT_QK(sn0, sn1, Kl, 1); AT_QK(sn0, sn1, Kl, 2); AT_QK(sn0, sn1, Kl, 3); if (!FIXED) { AT_DECIDE(sn0, sn1, t + 1, false); } else { AT_MASK(sn0, sn1, t + 1); } } \
            if (hc_) { AT_VRD(Vl); AT_PV(Vl, 0, pc0, 0); AT_PV(Vl, 1, pc0, 1); AT_PV(Vl, 2, pc1, 0); AT_PV(Vl, 3, pc1, 1); } \
            if (have_next) { AT_EXP8(pc0, sn0, 0); AT_EXP8(pc0, sn0, 1); AT_EXP8(pc1, sn1, 0); AT_EXP8(pc1, sn1, 1); } \
        } \
        if (resc) { \
            _Pragma("unroll") \
            for (int i = 0; i < 16; ++i) { o0[i] *= fsave; o1[i] *= fsave; } \
            resc = false; } \
        if (t + 2 < ntiles) AT_STK(t & 1, KST); \
        if (t + 1 < ntiles) AT_STV((t + 1) & 1, VST); \
        __syncthreads(); \
        have_cur = have_next; \
    } while (0)
    if constexpr (!WINDOW) {
        u32x4 kreg2, vreg2;
        if (ntiles > 2) kreg2 = AT_LDK(AT_KEY(2));
        vreg2 = AT_LDV(AT_KEY(1));
        for (int t2 = 0; t2 < ntiles - 2; t2 += 2) {
            { const int t = t2; AT_ITER(t, 1, kreg, vreg, kreg2, vreg2, 1); }
            { const int t = t2 + 1; AT_ITER(t, 1, kreg2, vreg2, kreg, vreg, 1); }
        }
        { const int t = ntiles - 2; AT_ITER(t, 1, kreg, vreg, kreg2, vreg2, 1); }
        { const int t = ntiles - 1; AT_ITER(t, 1, kreg2, vreg2, kreg, vreg, 2); }
    } else {
        for (int t = 0; t < ntiles; ++t) { AT_ITER(t, 0, kreg, vreg, kreg, vreg, 0); }
    }
#undef AT_ITER
#undef AT_KEY
#undef AT_SKIP
#undef AT_LDK
#undef AT_LDV
#undef AT_STK
#undef AT_STV
#undef AT_QK
#undef AT_KRD
#undef AT_VRD
#undef AT_SUM
#undef AT_PV
#undef AT_EXP8
#undef AT_DECIDE
#undef AT_MASK
    const float lt = swap_sum(lrun);
    const float inv = 1.0f / lt;
    bf16_t* orow = Op + (size_t)(wid * 32 + r32) * 1024 + 4 * hi;
#pragma unroll
    for (int g = 0; g < 4; ++g) {
        u32x2 w0, w1;
        w0.x = cvtpk(o0[4 * g + 0] * inv, o0[4 * g + 1] * inv); w0.y = cvtpk(o0[4 * g + 2] * inv, o0[4 * g + 3] * inv);
        w1.x = cvtpk(o1[4 * g + 0] * inv, o1[4 * g + 1] * inv); w1.y = cvtpk(o1[4 * g + 2] * inv, o1[4 * g + 3] * inv);
        *(u32x2*)(orow + 8 * g) = w0; *(u32x2*)(orow + 32 + 8 * g) = w1;
    }
}

template <int GI>
DI void pool_unit_t(int rt, const bf16_t* U, const bf16_t* WpT, const float* pscale, bf16_t* MIX) {
    constexpr int g = GI, w = 2 << GI, hw = w >> 1;
    int tid_ = threadIdx.x; asm volatile("" : "+v"(tid_));
    const int tid = tid_, lane = tid & 63, fr = lane & 15, fq = lane >> 4; const int wid = __builtin_amdgcn_readfirstlane(tid >> 6);
    const int row = rt * 128 + wid * 16 + fr;
    const int rlq = row % GROWS;
    const bool lat = rlq < GLAT;
    const int t = lat ? (rlq & (SEQ - 1)) : ((rlq - GLAT) & (CTX - 1));
    const int S = lat ? SEQ : CTX;
    const int base = row - t;
    const int lo = (t - hw) < 0 ? 0 : (t - hw), hi = (t + hw) > S ? S : (t + hw);
    const float icnt = 1.0f / (float)(hi - lo);
    bf16x8 af[4];
#pragma unroll
    for (int ks = 0; ks < 4; ++ks) {
        const int c0 = g * 128 + 32 * ks + 8 * fq;
        u32x4 uv[w];
#pragma unroll
        for (int j = 0; j < w; ++j) {
            const int p = t - hw + j; const bool ok = (p >= 0 && p < S);
            uv[j] = *(const u32x4*)(U + (size_t)(base + (ok ? p : t)) * 512 + c0);
        }
        const u32x4 us = *(const u32x4*)(U + (size_t)row * 512 + c0);
        float sum[8];
#pragma unroll
        for (int e = 0; e < 8; ++e) sum[e] = 0.f;
#pragma unroll
        for (int j = 0; j < w; ++j) {
            const int p = t - hw + j; const float wt = (p >= 0 && p < S) ? 1.0f : 0.0f;
            sum[0] += wt * bflo(uv[j].x); sum[1] += wt * bfhi(uv[j].x); sum[2] += wt * bflo(uv[j].y); sum[3] += wt * bfhi(uv[j].y);
            sum[4] += wt * bflo(uv[j].z); sum[5] += wt * bfhi(uv[j].z); sum[6] += wt * bflo(uv[j].w); sum[7] += wt * bfhi(uv[j].w);
        }
        const float u0 = bflo(us.x), u1 = bfhi(us.x), u2 = bflo(us.y), u3 = bfhi(us.y), u4 = bflo(us.z), u5 = bfhi(us.z), u6 = bflo(us.w), u7 = bfhi(us.w);
        u32x4 d; d.x = cvtpk(sum[0] * icnt - u0, sum[1] * icnt - u1); d.y = cvtpk(sum[2] * icnt - u2, sum[3] * icnt - u3);
        d.z = cvtpk(sum[4] * icnt - u4, sum[5] * icnt - u5); d.w = cvtpk(sum[6] * icnt - u6, sum[7] * icnt - u7);
        af[ks] = __builtin_bit_cast(bf16x8, d);
    }
    const bf16_t* wp = WpT + (size_t)g * 128 * 128;
#pragma unroll
    for (int nt = 0; nt < 8; ++nt) {
        f32x4 acc = {0.f, 0.f, 0.f, 0.f};
#pragma unroll
        for (int ks = 0; ks < 4; ++ks) {
            const bf16x8 bfrag = *(const bf16x8*)(wp + (size_t)(16 * nt + fr) * 128 + 32 * ks + 8 * fq);
            acc = __builtin_amdgcn_mfma_f32_16x16x32_bf16(bfrag, af[ks], acc, 0, 0, 0);
        }
        const int n = g * 128 + 16 * nt + 4 * fq;
        const f32x4 ps = *(const f32x4*)(pscale + n);
        u32x2 w2; w2.x = cvtpk(acc[0] * ps[0], acc[1] * ps[1]); w2.y = cvtpk(acc[2] * ps[2], acc[3] * ps[3]);
        *(u32x2*)(MIX + (size_t)row * 1024 + 512 + n) = w2;
    }
}
DI void pool_unit(int rt, int g, const bf16_t* U, const bf16_t* WpT, const float* pscale, bf16_t* MIX) {
    if (g == 0) pool_unit_t<0>(rt, U, WpT, pscale, MIX);
    else if (g == 1) pool_unit_t<1>(rt, U, WpT, pscale, MIX);
    else if (g == 2) pool_unit_t<2>(rt, U, WpT, pscale, MIX);
    else pool_unit_t<3>(rt, U, WpT, pscale, MIX);
}

#define XB_TMO      128
#define XB_XCNT(j)  (256  + 64 * (j))
#define XB_XSUB(j)  (1280 + 64 * (j))
#define XB_XGEN(j)  (2304 + 64 * (j))
#define XB_TOP      3328
#define XB_TOPGEN   3392
#define XCD_BAR_WORDS 3456
#define XB_SPIN_CAP (1u << 18)
__device__ __forceinline__ unsigned xb_ld(unsigned* p)              { return __hip_atomic_load(p, __ATOMIC_RELAXED, __HIP_MEMORY_SCOPE_AGENT); }
__device__ __forceinline__ unsigned xb_add(unsigned* p, unsigned v) { return __hip_atomic_fetch_add(p, v, __ATOMIC_RELAXED, __HIP_MEMORY_SCOPE_AGENT); }
__device__ __forceinline__ unsigned xb_xcc_id() { return (unsigned)__builtin_amdgcn_s_getreg((3 << 11) | 20) & 0xFu; }
#define XB_SPIN(cond, bar) do { unsigned _sp = 0; while (cond) { __builtin_amdgcn_s_sleep(1); \
    if ((++_sp & 255u) == 0u) { if (xb_ld(&(bar)[XB_TMO])) break; if (_sp > XB_SPIN_CAP) { atomicAdd(&(bar)[XB_TMO], 1u); break; } } } } while (0)
struct XcdBarrier { unsigned* bar; unsigned x; volatile LAS unsigned* st; unsigned gsize; };
__device__ __forceinline__ XcdBarrier xcd_barrier_post(unsigned* bar, volatile LAS unsigned* st, unsigned gsize) {
    XcdBarrier b; b.bar = bar; b.x = xb_xcc_id(); b.st = st; b.gsize = gsize;
    if (threadIdx.x == 0) (void)xb_add(&bar[XB_XCNT(b.x)], 1u);
    return b;
}
__device__ __forceinline__ void xcd_barrier_complete(unsigned* bar, unsigned x, unsigned G, unsigned& nloc, unsigned& nx) {
    unsigned sum, cnt, mine, sp = 0u;
    for (;;) {
        sum = 0u; cnt = 0u; mine = 0u;
#pragma unroll
        for (unsigned j = 0; j < 16; ++j) { const unsigned c = xb_ld(&bar[XB_XCNT(j)]); sum += c; cnt += (c > 0u) ? 1u : 0u; mine = (j == x) ? c : mine; }
        if (sum == G) break;
        __builtin_amdgcn_s_sleep(1);
        if ((++sp & 255u) == 0u) { if (xb_ld(&bar[XB_TMO])) break; if (sp > XB_SPIN_CAP) { atomicAdd(&bar[XB_TMO], 1u); break; } }
    }
    nloc = mine > 0u ? mine : 1u; nx = cnt > 0u ? cnt : 1u;
}
__device__ __forceinline__ void xcd_barrier(const XcdBarrier& b) {
    asm volatile("s_waitcnt vmcnt(0)" ::: "memory");
    __syncthreads();
    if (threadIdx.x == 0) {
        unsigned* bar = b.bar; asm volatile("" : "+s"(bar));
        unsigned bx_ = b.x; asm volatile("" : "+s"(bx_));
        __builtin_amdgcn_s_waitcnt(0);
        unsigned nloc = b.st[0], nx = b.st[1];
        if (nloc == 0u) { xcd_barrier_complete(bar, bx_, b.gsize, nloc, nx); b.st[0] = nloc; b.st[1] = nx; }
        const unsigned old = xb_add(&bar[XB_XSUB(bx_)], 1u);
        const unsigned gen = old / nloc;
        if (old + 1u == (gen + 1u) * nloc) {
            __builtin_amdgcn_fence(__ATOMIC_RELEASE, "agent");
            asm volatile("s_waitcnt vmcnt(0)" ::: "memory");
            const unsigned og = xb_add(&bar[XB_TOP], 1u);
            const unsigned tg = og / nx;
            if (og + 1u == (tg + 1u) * nx) xb_add(&bar[XB_TOPGEN], 1u);
            else XB_SPIN(xb_ld(&bar[XB_TOPGEN]) == tg, bar);
            __builtin_amdgcn_fence(__ATOMIC_ACQUIRE, "agent");
            xb_add(&bar[XB_XGEN(bx_)], 1u);
            asm volatile("s_waitcnt vmcnt(0)" ::: "memory");
        } else {
            XB_SPIN(xb_ld(&bar[XB_XGEN(bx_)]) == gen, bar);
            __builtin_amdgcn_fence(__ATOMIC_ACQUIRE, "agent");
            asm volatile("s_waitcnt vmcnt(0)" ::: "memory");
        }
    }
    __syncthreads();
}

struct Args { const float* in[21]; float* out; unsigned char* ws; int never; int pad; };
constexpr size_t CTL_FLAG = 31744;
constexpr int STAGGER_SPIN = 0;

__global__ void __launch_bounds__(512, 2) fwd_megakernel(Args args) {
    extern __shared__ __attribute__((aligned(16))) unsigned char lds_raw[];
    LAS unsigned char* lds = (LAS unsigned char*)lds_raw;
    cg::grid_group grid = cg::this_grid();
    const int tid = threadIdx.x; const int wave = __builtin_amdgcn_readfirstlane(tid >> 6);
    const int G = gridDim.x, bx = blockIdx.x;
    const int grp = (bx >> 3) & 1, c = ((bx >> 4) << 3) | (bx & 7), Gg = G >> 1;
    volatile LAS unsigned* xst = (volatile LAS unsigned*)(lds + LDS_BYTES - 16);
    if (tid < 4) xst[tid] = 0u;
    __syncthreads();
    XcdBarrier xbar = xcd_barrier_post((unsigned*)args.ws + grp * 4096, xst, (unsigned)Gg);
    XcdBarrier gbar = xcd_barrier_post((unsigned*)args.ws + 2 * 4096, xst + 2, (unsigned)G);
#define GBAR() xcd_barrier(xbar)
    unsigned char* ws = args.ws;
    unsigned* flagw = (unsigned*)(ws + CTL_FLAG);
    const float* x_in = args.in[0]; const float* c_in = args.in[1]; const float* ctx_in = args.in[2]; const float* cctx_in = args.in[3];
    const float* w_mod = args.in[4]; const float* b_mod = args.in[5];
    const float* g_pre_mix = args.in[6]; const float* g_post_mix = args.in[7]; const float* g_pre_ffn = args.in[8]; const float* g_post_ffn = args.in[9];
    const float* we_in = args.in[10]; const float* we_out = args.in[11]; const float* we_qg = args.in[12]; const float* we_kg = args.in[13];
    const float* we_pool = args.in[14]; const float* we_pscale = args.in[15];
    const float* wo_in = args.in[16]; const float* wo_out = args.in[17]; const float* wo_sink = args.in[18];
    const float* w_f1 = args.in[19]; const float* w_f2 = args.in[20];
    float* out = args.out;
    float* MOD = (float*)(ws + WS_MOD); float* PART = (float*)(ws + WS_PART); float* PART2 = (float*)(ws + WS_PART2); bf16_t* Y2 = (bf16_t*)(ws + WS_Y2);
    float* XC = (float*)(ws + WS_XC);
    bf16_t* H = (bf16_t*)(ws + WS_H); bf16_t* Y = (bf16_t*)(ws + WS_Y);
    unsigned char* arena = ws + WS_Q + (size_t)grp * (216 * MiB);
    bf16_t* Ub = (bf16_t*)(arena + 108 * MiB) - (size_t)grp * GROWS * 512; bf16_t* MIX = (bf16_t*)(arena + 144 * MiB) - (size_t)grp * GROWS * 1024;
    bf16_t* ACT = (bf16_t*)arena - (size_t)grp * GROWS * FFN;
    const int gw = c * 8 + wave, ngw = Gg * 8;
    const int xl = c & 7, jl = c >> 3;

    for (int it = bx; it < 4 * 48; it += G) mod_item(it, c_in, cctx_in, w_mod, b_mod, MOD, lds);
    for (int l = 0; l < NLAYER; ++l) prep_layer(l, bx, G, ws, lds, we_in, we_out, we_pool, wo_in, wo_out, w_f1, w_f2);
    if (args.never) grid.sync();
    xcd_barrier(gbar);
    {
        RowArgs a{}; a.xinL = x_in; a.xinC = ctx_in; a.H = H; a.gpre = g_pre_mix; a.sh = MOD; a.sc = MOD + 1024; a.M = 36864; a.upd = 0; a.upd2 = 0; a.wr = 0; a.nxt = 1;
        row_phase(a, gw, ngw, grp);
    }
    GBAR();
    for (int l = 0; l < NLAYER; ++l) {
        const int li = l >> 1; const bool ev = (l & 1) == 0; const bool with_ctx = l < NLAYER - 1;
        const int Mlog = with_ctx ? 36864 : 32768;
        unsigned char* wl = ws + WS_W + (size_t)l * WL_STRIDE;
        float* MODl = MOD + (size_t)l * 33 * 6144;
        bf16_t* Qb = (bf16_t*)arena - (size_t)grp * GROWS * (ev ? 512 : 1024);
        bf16_t* Kb = (bf16_t*)(arena + 72 * MiB) - (size_t)(16 * grp) * KVR * (ev ? 128 : 256);
        bf16_t* Vt = (bf16_t*)(arena + 90 * MiB) - (size_t)(16 * grp) * (ev ? 2 : 4) * 64 * KVR;
        {
            pg8::Gemm g{H, (const bf16_t*)(wl + WL_IN), 36864, ev ? 1280 : 1536, 1024}; pg8::GroupOrder S; S.init(g.M, g.N, Gg, c, grp);
            LAS float* ropel = (LAS float*)(lds + 131072);
            rope_table(ropel); __syncthreads();
            EpiQKV E{ev ? 1 : 0, Qb, Kb, Vt, Ub, we_qg + li * 64, we_kg + li * 64, ropel, ev ? (unsigned*)nullptr : (unsigned*)(ws + 49152) + li * 640};
            pg8::gemm_phase<EpiQKV, pg8::GroupOrder>(lds, g, S, E);
        }
        GBAR();
        if (ev) {
            const int n_dense = 1024, n_ctx = with_ctx ? 128 : 0;
            float bref;
            { const int ln = tid & 63; float gq = fabsf(we_qg[li * 64 + ln]), gk = fabsf(we_kg[li * 64 + ln]);
#pragma unroll
              for (int o = 1; o < 64; o <<= 1) { gq = fmaxf(gq, __shfl_xor(gq, o)); gk = fmaxf(gk, __shfl_xor(gk, o)); }
              bref = __uint_as_float(__builtin_amdgcn_readfirstlane(__float_as_uint(64.0f * C2 * gq * gk * 1.02f + 0.25f))); }
            for (int u = c; u < n_dense + n_ctx; u += Gg) {
                int b, head, qrow0, na;
                if (u < n_dense) { int qb = u & 7; head = (u >> 3) & 7; int bl = u >> 6;
                    if (Gg == 128) { const int i = u >> 7, pr = (i >> 1) * 8 + xl, idx = (i & 1) * 16 + jl; bl = pr >> 1; head = (pr & 1) * 4 + (idx >> 3); qb = idx & 7; }
                    b = 16 * grp + bl; qrow0 = grp * GROWS + bl * SEQ + qb * 256; na = 32; }
                else { const int v = u - n_dense; head = v & 7; b = 16 * grp + (v >> 3); qrow0 = grp * GROWS + GLAT + (v >> 3) * CTX; na = 0; }
                const int kvh = head >> 2;
                if (bref <= 40.0f) attn_unit<false, false, true>(lds, Qb + (size_t)qrow0 * 512 + head * 64, 512, Kb + (size_t)b * KVR * 128 + kvh * 64, 128, Vt + (size_t)(b * 2 + kvh) * 64 * KVR,
                                                              MIX + (size_t)qrow0 * 1024 + head * 64, 0, na, 0, 0.f, bref);
                else attn_unit<false, false, false>(lds, Qb + (size_t)qrow0 * 512 + head * 64, 512, Kb + (size_t)b * KVR * 128 + kvh * 64, 128, Vt + (size_t)(b * 2 + kvh) * 64 * KVR,
                                                    MIX + (size_t)qrow0 * 1024 + head * 64, 0, na, 0, 0.f);
            }
            const int n_rt = Mlog / 128, n_pool = n_rt * 4;
            for (int u = c; u < n_pool; u += Gg) { const int tl = u % n_rt; const int rt = grp * (GROWS / 128) + tl;
                pool_unit(rt, u / n_rt, Ub, (const bf16_t*)(wl + WL_POOL), we_pscale + li * 512, MIX); }
        } else {
            const int n_win = 2048, n_ctx = with_ctx ? 256 : 0;
            for (int u = c; u < n_win + n_ctx; u += Gg) {
                if (u < n_win) {
                    int qb = u & 7, head = (u >> 3) & 15, bl = u >> 7;
                    if (Gg == 128) { const int i = u >> 7, pr = (i >> 1) * 8 + xl, idx = (i & 1) * 16 + jl; bl = pr >> 2; head = (pr & 3) * 4 + (idx >> 3); qb = ((idx & 7) + (i >> 1)) & 7; }
                    const int b = 16 * grp + bl; const int q0 = qb * 256, qrow0 = grp * GROWS + bl * SEQ + q0, kvh = head >> 2;
                    const int klo = (q0 - 128) < 0 ? 0 : (q0 - 128), khi = (q0 + 384) > SEQ ? SEQ : (q0 + 384);
                    const float sk = wo_sink[li * 16 + head] * LOG2E;
                    unsigned* mwp = (unsigned*)(ws + 49152) + li * 640 + b * 20;
                    const float mq2 = __uint_as_float(__builtin_amdgcn_readfirstlane(__hip_atomic_load(mwp + head, __ATOMIC_RELAXED, __HIP_MEMORY_SCOPE_AGENT)));
                    const float mk2 = __uint_as_float(__builtin_amdgcn_readfirstlane(__hip_atomic_load(mwp + 16 + kvh, __ATOMIC_RELAXED, __HIP_MEMORY_SCOPE_AGENT)));
                    const float refw = fmaxf(sqrtf(mq2 * mk2) * 1.02f + 0.25f, sk);
                    if (refw <= 50.0f && sk >= -60.0f)
                        attn_unit<true, true, true>(lds, Qb + (size_t)qrow0 * 1024 + head * 64, 1024, Kb + (size_t)b * KVR * 256 + kvh * 64, 256, Vt + (size_t)(b * 4 + kvh) * 64 * KVR,
                                                    MIX + (size_t)qrow0 * 1024 + head * 64, klo >> 6, (khi - klo) >> 6, q0, sk, refw);
                    else
                    attn_unit<true, true>(lds, Qb + (size_t)qrow0 * 1024 + head * 64, 1024, Kb + (size_t)b * KVR * 256 + kvh * 64, 256, Vt + (size_t)(b * 4 + kvh) * 64 * KVR,
                                          MIX + (size_t)qrow0 * 1024 + head * 64, klo >> 6, (khi - klo) >> 6, q0, sk);
                } else {
                    const int v = u - n_win, head = v & 15, b = 16 * grp + (v >> 4); const int qrow0 = grp * GROWS + GLAT + (v >> 4) * CTX, kvh = head >> 2;
                    const float sk = wo_sink[li * 16 + head] * LOG2E;
                    attn_unit<false, true>(lds, Qb + (size_t)qrow0 * 1024 + head * 64, 1024, Kb + (size_t)b * KVR * 256 + kvh * 64, 256, Vt + (size_t)(b * 4 + kvh) * 64 * KVR,
                                           MIX + (size_t)qrow0 * 1024 + head * 64, 0, 0, 0, sk);
                }
            }
        }
        GBAR();
        {
            pg8::Gemm g{MIX, (const bf16_t*)(wl + WL_OUT), Mlog, 1024, 1024}; pg8::GroupOrder S; S.init(g.M, g.N, Gg, c, grp);
            EpiY E{Y, PART};
            pg8::gemm_phase<EpiY, pg8::GroupOrder>(lds, g, S, E);
        }
        GBAR();
        {
            RowArgs a{}; a.xinL = (l == 0) ? x_in : out; a.xinC = (l == 0) ? ctx_in : XC; a.xoutL = out; a.xoutC = XC;
            a.Y = Y; a.PART = PART; a.gate = MODl + 2048; a.gpost = g_post_mix + l * 1024;
            a.H = H; a.gpre = g_pre_ffn + l * 1024; a.sh = MODl + 3072; a.sc = MODl + 4096; a.M = Mlog; a.upd = 1; a.upd2 = 0; a.wr = 0; a.nxt = 1; a.xin16 = (l > 0) ? 1 : 0;
            row_phase(a, gw, ngw, grp);
        }
        GBAR();
        {
            pg8::Gemm g{H, (const bf16_t*)(wl + WL_F1), Mlog, 2 * FFN, 1024}; pg8::GroupOrder S; S.init(g.M, g.N, Gg, c, grp);
            EpiSwiGLU E{ACT};
            pg8::gemm_phase<EpiSwiGLU, pg8::GroupOrder>(lds, g, S, E);
        }
        GBAR();
        {
            pg8::Gemm g{ACT, (const bf16_t*)(wl + WL_F2), Mlog, 1024, FFN}; pg8::GroupOrder S; S.init(g.M, g.N, Gg, c, grp);
            EpiY E{Y2, PART2};
            pg8::gemm_phase<EpiY, pg8::GroupOrder>(lds, g, S, E);
        }
        GBAR();
        {
            RowArgs a{}; a.xinL = (l == 0) ? x_in : out; a.xinC = (l == 0) ? ctx_in : XC; a.xoutL = out; a.xoutC = XC;
            a.Y = Y; a.PART = PART; a.gate = MODl + 2048; a.gpost = g_post_mix + l * 1024;
            a.Y2 = Y2; a.PART2 = PART2; a.gate2 = MODl + 5120; a.gpost2 = g_post_ffn + l * 1024;
            a.H = H; a.gpre = g_pre_mix + (l + 1 < NLAYER ? l + 1 : l) * 1024; a.sh = MODl + 33 * 6144; a.sc = MODl + 33 * 6144 + 1024; a.M = Mlog; a.upd = 1; a.upd2 = 1; a.wr = 1; a.nxt = with_ctx ? 1 : 0; a.xin16 = (l > 0) ? 1 : 0; a.xout16 = with_ctx ? 1 : 0;
            row_phase(a, gw, ngw, grp);
        }
        if (l + 1 < NLAYER) GBAR();
    }
#undef GBAR
}

extern "C" void kernel_launch(void* const* d_in, const int* in_sizes, int n_in, void* d_out, int out_size, void* d_ws, size_t ws_size, hipStream_t stream) {
    static int grid = 0;
    if (grid == 0) {
        if (n_in != 21 || out_size != NL * DM || ws_size < WS_END) { fprintf(stderr, "kernel_launch: unexpected shapes (n_in %d out %d ws %zu)\n", n_in, out_size, ws_size); grid = -1; return; }
        int dev = 0, cus = 0, per_cu = 0;
        (void)hipGetDevice(&dev);
        (void)hipDeviceGetAttribute(&cus, hipDeviceAttributeMultiprocessorCount, dev);
        if (hipFuncSetAttribute((const void*)fwd_megakernel, hipFuncAttributeMaxDynamicSharedMemorySize, LDS_BYTES) != hipSuccess) { fprintf(stderr, "kernel_launch: hipFuncSetAttribute failed\n"); }
        if (hipOccupancyMaxActiveBlocksPerMultiprocessor(&per_cu, (const void*)fwd_megakernel, 512, LDS_BYTES) != hipSuccess || per_cu < 1) { fprintf(stderr, "kernel_launch: occupancy query says %d\n", per_cu); per_cu = 1; }
        (void)hipGetLastError();
        if (per_cu > 1) per_cu = 1;
        grid = (cus * per_cu) & ~1;
    }
    if (grid < 0) return;
    if (hipMemsetAsync(d_ws, 0, 57344, stream) != hipSuccess) { fprintf(stderr, "kernel_launch: memset of barrier words failed\n"); return; }
    Args a{};
    for (int i = 0; i < 21; ++i) a.in[i] = (const float*)d_in[i];
    a.out = (float*)d_out; a.ws = (unsigned char*)d_ws;
    void* kargs[] = {&a};
    hipError_t e = hipLaunchCooperativeKernel((const void*)fwd_megakernel, dim3(grid), dim3(512), kargs, LDS_BYTES, stream);
    if (e != hipSuccess) fprintf(stderr, "cooperative launch failed: %s (grid %d)\n", hipGetErrorString(e), grid);
}
```

```cpp
#include <hip/hip_runtime.h>
#include <hip/hip_cooperative_groups.h>
#include <cstdio>
#include <cstdint>
namespace cg = cooperative_groups;

#define DI __device__ __forceinline__
#define LAS __attribute__((address_space(3)))
typedef unsigned short bf16_t;
typedef short bf16x8 __attribute__((ext_vector_type(8)));
typedef short s16x4 __attribute__((ext_vector_type(4)));
typedef float f32x4 __attribute__((ext_vector_type(4)));
typedef float f32x16 __attribute__((ext_vector_type(16)));
typedef unsigned u32x4 __attribute__((ext_vector_type(4)));
typedef unsigned u32x2 __attribute__((ext_vector_type(2)));
typedef float f32x2_t __attribute__((ext_vector_type(2)));
typedef __bf16 bf16x2_t __attribute__((ext_vector_type(2)));

DI unsigned cvtpk(float lo, float hi) { f32x2_t v = {lo, hi}; bf16x2_t b = __builtin_convertvector(v, bf16x2_t); return __builtin_bit_cast(unsigned, b); }
DI float bf2f(unsigned short b) { return __uint_as_float(((unsigned)b) << 16); }
DI float bflo(unsigned w) { return __uint_as_float(w << 16); }
DI float bfhi(unsigned w) { return __uint_as_float(w & 0xffff0000u); }

constexpr int DM = 1024, NBATCH = 32, SEQ = 2048, CTX = 256, NLAYER = 4;
constexpr int NL = NBATCH * SEQ;
constexpr int NC = NBATCH * CTX;
constexpr int NT = NL + NC;
constexpr int GROWS = 36864, GLAT = 32768, GPAN = 144;
constexpr int KVR = SEQ + CTX;
constexpr int FFN = 2816;
constexpr float EPS = 1e-6f;
constexpr float LOG2E = 1.4426950408889634f;
constexpr float C2 = 0.125f * LOG2E;

constexpr size_t MiB = 1u << 20;
constexpr size_t WS_MOD = 1 * MiB;
constexpr size_t WS_ROPE = 5 * MiB;
constexpr size_t WS_PART = 6 * MiB;
constexpr size_t WS_PART2 = 11 * MiB;
constexpr size_t WS_W = 16 * MiB;
constexpr size_t WL_IN = 0, WL_OUT = 3 * MiB, WL_POOL = 5 * MiB, WL_F1 = 6 * MiB, WL_F2 = 17 * MiB, WL_STRIDE = 24 * MiB;
constexpr size_t WS_XC = 112 * MiB;
constexpr size_t WS_H = 144 * MiB;
constexpr size_t WS_Y = 288 * MiB;
constexpr size_t WS_Q = 432 * MiB;
constexpr size_t WS_K = 576 * MiB;
constexpr size_t WS_VT = 612 * MiB;
constexpr size_t WS_U = 648 * MiB;
constexpr size_t WS_MIX = 720 * MiB;
constexpr size_t WS_ACT = 432 * MiB;
constexpr size_t WS_Y2 = 864 * MiB;
constexpr size_t WS_END = 1008 * MiB;
constexpr int LDS_BYTES = 147456;

namespace pg8 {
#define PG8_LAS __attribute__((address_space(3)))
constexpr int BM = 256, BK = 64, HALF = 128, HTB = HALF * BK * 2, STAGE_BYTES = 8 * HTB, NXCD = 8, WGM = 4;
__host__ __device__ __forceinline__ int lds_byte(int r, int c) { const int st = (r >> 4) * 2 + (c >> 5), rr = r & 15, cc = c & 31, ob = rr * 64 + cc * 2; return st * 1024 + (ob ^ (((ob >> 9) & 1) << 5)); }
__host__ __device__ __forceinline__ void stage_rc(int b, int& R, int& C) { const int st = b / 1024, sb = b % 1024, swz = sb ^ (((sb >> 9) & 1) << 5); R = (st >> 1) * 16 + swz / 64; C = (st & 1) * 32 + (swz % 64) / 2; }
struct Unit { int pm, pn; };
struct Gemm { const bf16_t* A; const bf16_t* Bt; int M, N, K; };
struct StaticOrder {
    int nM, nN, nwg, G, c;
    __host__ __device__ void init(int M, int N, int G_, int c_) { nM = M / BM; nN = N / BM; nwg = nM * nN; G = G_; c = c_; }
    __host__ __device__ bool next(int i, Unit& u) const {
        const long L = (long)i * G + c; if (L >= nwg) return false;
        int wgid = (int)L; { const int q = nwg / NXCD, r = nwg % NXCD, xcd = wgid % NXCD, off = wgid / NXCD; wgid = (xcd < r ? xcd * (q + 1) : r * (q + 1) + (xcd - r) * q) + off; }
        const int nig = WGM * nN, gid = wgid / nig, fm = gid * WGM, gsz = (nM - fm) < WGM ? (nM - fm) : WGM;
        u.pm = fm + ((wgid % nig) % gsz); u.pn = (wgid % nig) / gsz; return true;
    }
};
struct GroupOrder {
    StaticOrder base; int g;
    __host__ __device__ void init(int Mlog, int N, int Gg, int c, int g_) { base.init(Mlog, N, Gg, c); g = g_; }
    __host__ __device__ bool next(int i, Unit& u) const {
        if (!base.next(i, u)) return false;
        u.pm += 144 * g; return true;
    }
};
template <class Epi, class Sched>
__device__ __forceinline__ void gemm_phase(PG8_LAS unsigned char* lds, const Gemm g, const Sched& S, const Epi& E) {
    int tid_ = threadIdx.x; asm volatile("" : "+v"(tid_));
    const int tid = tid_, wid = __builtin_amdgcn_readfirstlane(tid >> 6), lane = tid & 63, wr = wid >> 2, wc = wid & 3, fr = lane & 15, fq = lane >> 4;
    const int K = g.K, nt = K / BK;
    unsigned voffA[2], voffB[2];
#pragma unroll
    for (int i = 0; i < 2; ++i) { int R, C; stage_rc(tid * 16 + i * 8192, R, C); voffA[i] = (unsigned)(R * K + C) * 2u; voffB[i] = voffA[i]; }
    const size_t kstep = (size_t)(BK * 2);
    const size_t hstep = (size_t)HALF * K * 2;
    const size_t tstep = 2 * hstep;
    const unsigned ldsw = (unsigned)wid * 1024u;
    const int aoff = lds_byte(wr * 64 + fr, fq * 8), boff = lds_byte(wc * 32 + fr, fq * 8);
#define PG8_SA(b, h) (((b) * 2 + (h)) * HTB)
#define PG8_SB(b, h) ((4 + (b) * 2 + (h)) * HTB)
#define PG8_STAGE(bufoff, gbase, voff) do { _Pragma("unroll") for (int _i = 0; _i < 2; ++_i) \
        __builtin_amdgcn_global_load_lds((const unsigned*)((const char*)(gbase) + (voff)[_i]), (PG8_LAS unsigned*)(lds + (bufoff) + ldsw + _i * 8192), 16, 0, 0); } while (0)
#define PG8_LDA(dst, b, h) do { _Pragma("unroll") for (int m = 0; m < 4; ++m) _Pragma("unroll") for (int k = 0; k < 2; ++k) dst[m][k] = *(const PG8_LAS bf16x8*)(lds + PG8_SA(b, h) + aoff + m * 2048 + k * 1024); } while (0)
#define PG8_LDB(dst, b, h) do { _Pragma("unroll") for (int n = 0; n < 2; ++n) _Pragma("unroll") for (int k = 0; k < 2; ++k) dst[n][k] = *(const PG8_LAS bf16x8*)(lds + PG8_SB(b, h) + boff + n * 2048 + k * 1024); } while (0)
#define PG8_MMA(ai, bj, At, Bt) do { __builtin_amdgcn_s_setprio(1); _Pragma("unroll") for (int m = 0; m < 4; ++m) _Pragma("unroll") for (int n = 0; n < 2; ++n) _Pragma("unroll") for (int k = 0; k < 2; ++k) \
        acc[ai][bj][m][n] = __builtin_amdgcn_mfma_f32_16x16x32_bf16(Bt[n][k], At[m][k], acc[ai][bj][m][n], 0, 0, 0); __builtin_amdgcn_s_setprio(0); } while (0)
#define PG8_WAIT_V(n) asm volatile("s_waitcnt vmcnt(" #n ")" ::: "memory")
#define PG8_WAIT_L(n) asm volatile("s_waitcnt lgkmcnt(" #n ")" ::: "memory")
#define PG8_BAR __builtin_amdgcn_s_barrier()
#define PG8_SCHED __builtin_amdgcn_sched_barrier(0)
    Unit cur, nxt; int ui = 0;
    if (!S.next(0, cur)) return;
    f32x4 acc[2][2][4][2];
#pragma unroll
    for (int a = 0; a < 2; ++a)
#pragma unroll
        for (int b = 0; b < 2; ++b)
#pragma unroll
            for (int m = 0; m < 4; ++m)
#pragma unroll
                for (int n = 0; n < 2; ++n) acc[a][b][m][n] = (f32x4){0.f, 0.f, 0.f, 0.f};
    bf16x8 At[4][2], B0[2][2], B1[2][2];
    const char* cA = (const char*)g.A + (size_t)cur.pm * tstep; const char* cB = (const char*)g.Bt + (size_t)cur.pn * tstep;
    PG8_STAGE(PG8_SB(0, 0), cB, voffB); PG8_STAGE(PG8_SB(0, 1), cB + hstep, voffB); PG8_STAGE(PG8_SA(0, 0), cA, voffA); PG8_STAGE(PG8_SA(0, 1), cA + hstep, voffA);
    if (wr == 1) PG8_BAR;
    PG8_WAIT_V(2); PG8_BAR;
    PG8_STAGE(PG8_SB(1, 0), cB + kstep, voffB); PG8_STAGE(PG8_SA(1, 0), cA + kstep, voffA); PG8_STAGE(PG8_SB(1, 1), cB + hstep + kstep, voffB);
    PG8_WAIT_V(6); PG8_BAR;
    for (;;) {
        const bool has_next = S.next(ui + 1, nxt);
        const char* nA = has_next ? (const char*)g.A + (size_t)nxt.pm * tstep : cA; const char* nB = has_next ? (const char*)g.Bt + (size_t)nxt.pn * tstep : cB;
        for (int t = 0; t < nt; t += 2) {
            const bool last = (t == nt - 2);
            const char* a1 = cA + (size_t)(t + 1) * kstep;
            const char* a2 = last ? nA : cA + (size_t)(t + 2) * kstep; const char* b2 = last ? nB : cB + (size_t)(t + 2) * kstep;
            const char* a3 = a2 + kstep; const char* b3 = b2 + kstep;
            PG8_LDB(B0, 0, 0); PG8_LDB(B1, 0, 1); PG8_SCHED; PG8_LDA(At, 0, 0); PG8_STAGE(PG8_SA(1, 1), a1 + hstep, voffA);
            PG8_WAIT_V(8); PG8_WAIT_L(0); PG8_BAR; PG8_MMA(0, 0, At, B0); PG8_MMA(0, 1, At, B1); PG8_BAR; PG8_SCHED;
            PG8_LDA(At, 0, 1); PG8_STAGE(PG8_SB(0, 0), b2, voffB); PG8_STAGE(PG8_SB(0, 1), b2 + hstep, voffB); PG8_STAGE(PG8_SA(0, 0), a2, voffA);
            PG8_WAIT_V(8); PG8_WAIT_L(0); PG8_BAR; PG8_MMA(1, 0, At, B0); PG8_MMA(1, 1, At, B1); PG8_BAR; PG8_SCHED;
            PG8_LDB(B0, 1, 0); PG8_LDB(B1, 1, 1); PG8_SCHED; PG8_LDA(At, 1, 0); PG8_STAGE(PG8_SA(0, 1), a2 + hstep, voffA);
            PG8_WAIT_V(8); PG8_WAIT_L(0); PG8_BAR; PG8_MMA(0, 0, At, B0); PG8_MMA(0, 1, At, B1); PG8_BAR; PG8_SCHED;
            PG8_LDA(At, 1, 1); PG8_STAGE(PG8_SB(1, 0), b3, voffB); PG8_STAGE(PG8_SB(1, 1), b3 + hstep, voffB); PG8_STAGE(PG8_SA(1, 0), a3, voffA);
            PG8_WAIT_V(8); PG8_WAIT_L(0); PG8_BAR; PG8_MMA(1, 0, At, B0); PG8_MMA(1, 1, At, B1); PG8_BAR; PG8_SCHED;
        }
        if (wr == 0) PG8_BAR;
        E(acc, cur, wr, wc, fr, fq);
        if (!has_next) break;
#pragma unroll
        for (int a = 0; a < 2; ++a)
#pragma unroll
            for (int b = 0; b < 2; ++b)
#pragma unroll
                for (int m = 0; m < 4; ++m)
#pragma unroll
                    for (int n = 0; n < 2; ++n) acc[a][b][m][n] = (f32x4){0.f, 0.f, 0.f, 0.f};
        cur = nxt; cA = nA; cB = nB; ++ui;
        if (wr == 1) PG8_BAR;
    }
    PG8_WAIT_V(0);
    PG8_BAR;
#undef PG8_SA
#undef PG8_SB
#undef PG8_STAGE
#undef PG8_LDA
#undef PG8_LDB
#undef PG8_MMA
#undef PG8_WAIT_V
#undef PG8_WAIT_L
#undef PG8_BAR
#undef PG8_SCHED
}
}

struct EpiQKV {
    int even;
    bf16_t* Q; bf16_t* Kb; bf16_t* Vt; bf16_t* U;
    const float* qg; const float* kg; const LAS float* rope; unsigned* maxw;
    DI void operator()(const f32x4 (&acc)[2][2][4][2], const pg8::Unit& u, int wr, int wc, int fr, int fq) const {
        int kind, head;
        const int pn = u.pn;
        if (even) { if (pn < 2) { kind = 0; head = pn * 4 + wc; } else if (pn == 2) { if (wc < 2) { kind = 1; head = wc; } else { kind = 2; head = wc - 2; } } else { kind = 3; head = (pn - 3) * 4 + wc; } }
        else { if (pn < 4) { kind = 0; head = pn * 4 + wc; } else if (pn == 4) { kind = 1; head = wc; } else { kind = 2; head = wc; } }
        const int qw = even ? 512 : 1024, kvw = even ? 128 : 256, nkv = even ? 2 : 4;
        const int gq = u.pm / GPAN, pl = u.pm - gq * GPAN;
        const bool lat = pl < 128;
        int b, pos0;
        if (lat) { b = 16 * gq + (pl >> 3); pos0 = (pl & 7) * 256; } else { b = 16 * gq + (pl - 128); pos0 = SEQ; }
        const int half = fq >> 1, f0 = 8 * (fq & 1);
        const int dbase = 32 * half + f0;
        f32x4 gn[2][2];
        const bool donorm = even && kind <= 1;
        if (donorm) { const float* gp = (kind == 0) ? qg : kg;
#pragma unroll
            for (int bj = 0; bj < 2; ++bj)
#pragma unroll
                for (int n = 0; n < 2; ++n) gn[bj][n] = *(const f32x4*)(gp + dbase + 16 * bj + 4 * n); }
        const float qs = (kind == 0) ? C2 : 1.0f;
        float rmaxn = 0.f;
#pragma unroll
        for (int ai = 0; ai < 2; ++ai)
#pragma unroll
            for (int m = 0; m < 4; ++m) {
                const int rl = 128 * ai + 64 * wr + 16 * m + fr;
                const size_t grow = (size_t)u.pm * 256 + rl;
                const int pos = pos0 + rl;
                f32x4 v[2][2];
#pragma unroll
                for (int bj = 0; bj < 2; ++bj)
#pragma unroll
                    for (int n = 0; n < 2; ++n) v[bj][n] = acc[ai][bj][m][n];
                if (kind <= 1) {
                    if (donorm) {
                        float ss = 0.f;
#pragma unroll
                        for (int bj = 0; bj < 2; ++bj)
#pragma unroll
                            for (int n = 0; n < 2; ++n) ss += (v[bj][n][0] * v[bj][n][0] + v[bj][n][1] * v[bj][n][1]) + (v[bj][n][2] * v[bj][n][2] + v[bj][n][3] * v[bj][n][3]);
                        ss += __shfl_xor(ss, 16); ss += __shfl_xor(ss, 32);
                        const float rstd = rsqrtf(ss * (1.0f / 64.0f) + EPS);
#pragma unroll
                        for (int bj = 0; bj < 2; ++bj)
#pragma unroll
                            for (int n = 0; n < 2; ++n) v[bj][n] = v[bj][n] * rstd * gn[bj][n];
                    }
                    if (lat) {
                        const int p = half ? (pos & 63) : (pos >> 6);
                        const LAS f32x4* rp = (const LAS f32x4*)(rope + (p * 16 + f0) * 2);
#pragma unroll
                        for (int n = 0; n < 2; ++n) {
                            const f32x4 cs0 = rp[2 * n], cs1 = rp[2 * n + 1];
                            const float c[4] = {cs0[0], cs0[2], cs1[0], cs1[2]}, s[4] = {cs0[1], cs0[3], cs1[1], cs1[3]};
#pragma unroll
                            for (int i = 0; i < 4; ++i) { const float a1 = v[0][n][i], a2 = v[1][n][i]; v[0][n][i] = a1 * c[i] - a2 * s[i]; v[1][n][i] = a2 * c[i] + a1 * s[i]; }
                        }
                    }
                    if (maxw) { float nn = 0.f;
#pragma unroll
                        for (int bj = 0; bj < 2; ++bj)
#pragma unroll
                            for (int n = 0; n < 2; ++n) nn += (v[bj][n][0] * v[bj][n][0] + v[bj][n][1] * v[bj][n][1]) + (v[bj][n][2] * v[bj][n][2] + v[bj][n][3] * v[bj][n][3]);
                        nn += __shfl_xor(nn, 16); nn += __shfl_xor(nn, 32); rmaxn = fmaxf(rmaxn, nn * qs * qs); }
                    bf16_t* dst = (kind == 0) ? (Q + grow * qw + head * 64) : (Kb + ((size_t)b * KVR + pos) * kvw + head * 64);
#pragma unroll
                    for (int bj = 0; bj < 2; ++bj) {
                        u32x4 w; w.x = cvtpk(v[bj][0][0] * qs, v[bj][0][1] * qs); w.y = cvtpk(v[bj][0][2] * qs, v[bj][0][3] * qs);
                        w.z = cvtpk(v[bj][1][0] * qs, v[bj][1][1] * qs); w.w = cvtpk(v[bj][1][2] * qs, v[bj][1][3] * qs);
                        *(u32x4*)(dst + dbase + 16 * bj) = w;
                    }
                } else if (kind == 2) {
                    const int posp = (pos & ~15) | (pos & 3) | ((pos & 4) << 1) | ((pos & 8) >> 1);
                    bf16_t* dst = Vt + ((size_t)(b * nkv + head) * 64) * KVR + posp;
#pragma unroll
                    for (int bj = 0; bj < 2; ++bj)
#pragma unroll
                        for (int n = 0; n < 2; ++n)
#pragma unroll
                            for (int i = 0; i < 4; ++i) { const int d = dbase + 16 * bj + 4 * n + i; dst[(size_t)d * KVR] = (bf16_t)(cvtpk(v[bj][n][i], 0.f) & 0xffffu); }
                } else {
                    bf16_t* dst = U + grow * 512 + head * 64;
#pragma unroll
                    for (int bj = 0; bj < 2; ++bj) {
                        u32x4 w; w.x = cvtpk(v[bj][0][0], v[bj][0][1]); w.y = cvtpk(v[bj][0][2], v[bj][0][3]);
                        w.z = cvtpk(v[bj][1][0], v[bj][1][1]); w.w = cvtpk(v[bj][1][2], v[bj][1][3]);
                        *(u32x4*)(dst + dbase + 16 * bj) = w;
                    }
                }
            }
        if (maxw && kind <= 1) {
            rmaxn = fmaxf(rmaxn, __shfl_xor(rmaxn, 1)); rmaxn = fmaxf(rmaxn, __shfl_xor(rmaxn, 2)); rmaxn = fmaxf(rmaxn, __shfl_xor(rmaxn, 4)); rmaxn = fmaxf(rmaxn, __shfl_xor(rmaxn, 8));
            if (fr == 0 && fq == 0) __hip_atomic_fetch_max(maxw + b * 20 + (kind == 0 ? head : 16 + head), __float_as_uint(rmaxn), __ATOMIC_RELAXED, __HIP_MEMORY_SCOPE_AGENT);
        }
    }
};

struct EpiY {
    bf16_t* Y; float* PART;
    DI void operator()(const f32x4 (&acc)[2][2][4][2], const pg8::Unit& u, int wr, int wc, int fr, int fq) const {
#pragma unroll
        for (int ai = 0; ai < 2; ++ai)
#pragma unroll
            for (int m = 0; m < 4; ++m) {
                const size_t row = (size_t)u.pm * 256 + 128 * ai + 64 * wr + 16 * m + fr;
                float ss = 0.f;
#pragma unroll
                for (int bj = 0; bj < 2; ++bj) {
                    const f32x4 v0 = acc[ai][bj][m][0], v1 = acc[ai][bj][m][1];
                    ss += (v0[0] * v0[0] + v0[1] * v0[1]) + (v0[2] * v0[2] + v0[3] * v0[3]) + (v1[0] * v1[0] + v1[1] * v1[1]) + (v1[2] * v1[2] + v1[3] * v1[3]);
                    u32x4 w; w.x = cvtpk(v0[0], v0[1]); w.y = cvtpk(v0[2], v0[3]); w.z = cvtpk(v1[0], v1[1]); w.w = cvtpk(v1[2], v1[3]);
                    *(u32x4*)(Y + row * 1024 + u.pn * 256 + 128 * bj + 32 * wc + 8 * fq) = w;
                }
                ss += __shfl_xor(ss, 16); ss += __shfl_xor(ss, 32);
                if (fq == 0) PART[row * 16 + u.pn * 4 + wc] = ss;
            }
    }
};

struct EpiSwiGLU {
    bf16_t* ACT;
    DI void operator()(const f32x4 (&acc)[2][2][4][2], const pg8::Unit& u, int wr, int wc, int fr, int fq) const {
#pragma unroll
        for (int ai = 0; ai < 2; ++ai)
#pragma unroll
            for (int m = 0; m < 4; ++m) {
                const size_t row = (size_t)u.pm * 256 + 128 * ai + 64 * wr + 16 * m + fr;
                float o[2][4];
#pragma unroll
                for (int n = 0; n < 2; ++n)
#pragma unroll
                    for (int i = 0; i < 4; ++i) { const float gt = acc[ai][0][m][n][i], up = acc[ai][1][m][n][i]; o[n][i] = gt * up * __builtin_amdgcn_rcpf(1.0f + __builtin_amdgcn_exp2f(gt)); }
                u32x4 w; w.x = cvtpk(o[0][0], o[0][1]); w.y = cvtpk(o[0][2], o[0][3]); w.z = cvtpk(o[1][0], o[1][1]); w.w = cvtpk(o[1][2], o[1][3]);
                *(u32x4*)(ACT + row * FFN + u.pn * 128 + 32 * wc + 8 * fq) = w;
            }
    }
};

DI int newrow(int type, int o) {
    if (type == 0) { const int ol = o & 255, bj = ol >> 7, wc = (ol >> 5) & 3, fq = (ol >> 3) & 3, n = (ol >> 2) & 1, i = ol & 3; return (o & ~255) + 128 * bj + 32 * wc + 16 * n + 4 * fq + i; }
    if (type == 1) { const int ol = o & 255, wc = ol >> 6, d = ol & 63, fq = 2 * (d >> 5) + ((d >> 3) & 1), bj = (d >> 4) & 1, n = (d >> 2) & 1, i = d & 3; return (o & ~255) + 128 * bj + 32 * wc + 16 * n + 4 * fq + i; }
    if (type == 2) { const int isu = o >= FFN ? 1 : 0, j = o - FFN * isu, pn = j >> 7, jj = j & 127, wc = jj >> 5, fq = (jj >> 3) & 3, n = (jj >> 2) & 1, i = jj & 3; return pn * 256 + 128 * isu + 32 * wc + 16 * n + 4 * fq + i; }
    return o;
}
DI void prep_item(const float* W, int K, int N, bf16_t* WT, int type, int item, LAS float* scr) {
    int tid_ = threadIdx.x; asm volatile("" : "+v"(tid_)); const int tid = tid_;
    const int nblk = N / 64, kb = item / nblk, nb = item % nblk, k0 = 64 * kb, n0 = 64 * nb;
    { const int r = tid >> 4, c4 = (tid & 15) * 4;
#pragma unroll
      for (int p = 0; p < 2; ++p) { const int kk = r + 32 * p; const f32x4 v = *(const f32x4*)(W + (size_t)(k0 + kk) * N + n0 + c4);
          scr[kk * 65 + c4 + 0] = v[0]; scr[kk * 65 + c4 + 1] = v[1]; scr[kk * 65 + c4 + 2] = v[2]; scr[kk * 65 + c4 + 3] = v[3]; } }
    __syncthreads();
    { const int n = tid >> 3, kc = (tid & 7) * 8; const LAS float* s = scr + kc * 65 + n;
      const float sc = (type == 2) ? ((n0 + n >= FFN) ? -0.6931471805599453f : -LOG2E) : 1.0f;
      u32x4 o; o.x = cvtpk(s[0 * 65] * sc, s[1 * 65] * sc); o.y = cvtpk(s[2 * 65] * sc, s[3 * 65] * sc); o.z = cvtpk(s[4 * 65] * sc, s[5 * 65] * sc); o.w = cvtpk(s[6 * 65] * sc, s[7 * 65] * sc);
      *(u32x4*)(WT + (size_t)newrow(type, n0 + n) * K + k0 + kc) = o; }
    __syncthreads();
}

DI void prep_layer(int l, int worker, int nworkers, unsigned char* ws, LAS unsigned char* lds, const float* we_in, const float* we_out, const float* we_pool,
                   const float* wo_in, const float* wo_out, const float* w_f1, const float* w_f2) {
    constexpr int I_IN = 384, I_OUT = 256, I_POOL = 16, I_F1 = 1408, I_F2 = 704, I_LAYER = I_IN + I_OUT + I_POOL + I_F1 + I_F2;
    const int li = l >> 1; const bool ev = (l & 1) == 0;
    unsigned char* wl = ws + WS_W + (size_t)l * WL_STRIDE;
    LAS float* scr = (LAS float*)lds;
    for (int it = worker; it < I_LAYER; it += nworkers) {
        int r = it;
        if (r < I_IN) { if (ev) { if (r < 320) prep_item(we_in + (size_t)li * 1024 * 1280, 1024, 1280, (bf16_t*)(wl + WL_IN), 1, r, scr); }
                        else prep_item(wo_in + (size_t)li * 1024 * 1536, 1024, 1536, (bf16_t*)(wl + WL_IN), 1, r, scr); continue; } r -= I_IN;
        if (r < I_OUT) { prep_item((ev ? we_out : wo_out) + (size_t)li * 1024 * 1024, 1024, 1024, (bf16_t*)(wl + WL_OUT), 0, r, scr); continue; } r -= I_OUT;
        if (r < I_POOL) { if (ev) { const int gq = r >> 2; prep_item(we_pool + ((size_t)li * 4 + gq) * 128 * 128, 128, 128, (bf16_t*)(wl + WL_POOL) + (size_t)gq * 128 * 128, 3, r & 3, scr); } continue; } r -= I_POOL;
        if (r < I_F1) { prep_item(w_f1 + (size_t)l * 1024 * 5632, 1024, 5632, (bf16_t*)(wl + WL_F1), 2, r, scr); continue; } r -= I_F1;
        prep_item(w_f2 + (size_t)l * FFN * 1024, FFN, 1024, (bf16_t*)(wl + WL_F2), 0, r, scr);
    }
}

DI void mod_item(int item, const float* c, const float* cctx, const float* w_mod, const float* b_mod, float* MOD, LAS unsigned char* lds) {
    const int tid = threadIdx.x;
    const int l = item / 48, n0 = (item % 48) * 128;
    LAS float* S = (LAS float*)lds;
    for (int idx = tid; idx < 33 * 1024; idx += 512) { const int b = idx >> 10, k = idx & 1023; const float cv = (b < 32) ? c[b * 1024 + k] : cctx[k]; S[idx] = cv / (1.0f + __expf(-cv)); }
    __syncthreads();
    const int lane = tid & 63, kq = tid >> 6;
    float acc0[33], acc1[33];
#pragma unroll
    for (int b = 0; b < 33; ++b) { acc0[b] = 0.f; acc1[b] = 0.f; }
    const float* W = w_mod + (size_t)l * 1024 * 6144 + n0 + lane;
#pragma unroll 2
    for (int k = kq * 128; k < kq * 128 + 128; k += 4) {
        float wa[4], wb[4];
#pragma unroll
        for (int i = 0; i < 4; ++i) { wa[i] = __builtin_nontemporal_load(W + (size_t)(k + i) * 6144); wb[i] = __builtin_nontemporal_load(W + (size_t)(k + i) * 6144 + 64); }
#pragma unroll
        for (int b = 0; b < 33; ++b) { const f32x4 sv = *(const LAS f32x4*)(S + b * 1024 + k);
            acc0[b] += (sv[0] * wa[0] + sv[1] * wa[1]) + (sv[2] * wa[2] + sv[3] * wa[3]);
            acc1[b] += (sv[0] * wb[0] + sv[1] * wb[1]) + (sv[2] * wb[2] + sv[3] * wb[3]); }
    }
    __syncthreads();
    LAS float* red = (LAS float*)lds;
#pragma unroll
    for (int b = 0; b < 33; ++b) { red[(kq * 33 + b) * 128 + lane] = acc0[b]; red[(kq * 33 + b) * 128 + 64 + lane] = acc1[b]; }
    __syncthreads();
    for (int idx = tid; idx < 33 * 128; idx += 512) { const int b = idx >> 7, cc = idx & 127;
        float v = 0.f;
#pragma unroll
        for (int q = 0; q < 8; ++q) v += red[(q * 33 + b) * 128 + cc];
        MOD[((size_t)l * 33 + b) * 6144 + n0 + cc] = v + b_mod[l * 6144 + n0 + cc]; }
    __syncthreads();
}

DI void rope_table(LAS float* rope) {
    for (int idx = threadIdx.x; idx < 1024; idx += 512) {
        const int pos = idx >> 4, f = idx & 15;
        double fr = 1.0; const double q = 0.56234132519034908;
        for (int i = 0; i < f; ++i) fr *= q;
        const float ang = (float)pos * (float)fr;
        double r = (double)ang; const double twopi = 6.283185307179586476925;
        const double kk = __builtin_rint(r * (1.0 / twopi)); r -= kk * twopi;
        const double r2 = r * r; double s = r, ts = r, cc = 1.0, tc = 1.0;
#pragma unroll
        for (int n = 1; n <= 14; ++n) { ts *= r2 * (-1.0 / (double)((2 * n) * (2 * n + 1))); s += ts; tc *= r2 * (-1.0 / (double)((2 * n - 1) * (2 * n))); cc += tc; }
        rope[idx * 2] = (float)cc; rope[idx * 2 + 1] = (float)s;
    }
}

DI float wave_sum(float v) {
#pragma unroll
    for (int o = 1; o < 64; o <<= 1) v += __shfl_xor(v, o);
    return v;
}
struct RowArgs {
    const float* xinL; const float* xinC; float* xoutL; float* xoutC;
    const bf16_t* Y; const float* PART; const float* gate; const float* gpost;
    const bf16_t* Y2; const float* PART2; const float* gate2; const float* gpost2;
    bf16_t* H; const float* gpre; const float* sh; const float* sc;
    int M; int upd; int upd2; int wr; int nxt; int xin16; int xout16;
};
template <int NR>
DI void row_work(const RowArgs& a, int row0, int lane) {
    const int gq = row0 / GROWS, rl0 = row0 - gq * GROWS; const bool lat = rl0 < GLAT;
    const int bb = lat ? (16 * gq + (rl0 >> 11)) : 32;
    const size_t xrow0 = lat ? (size_t)(gq * GLAT + rl0) : (size_t)(gq * 4096 + rl0 - GLAT);
    const float* xi0 = (lat ? a.xinL : a.xinC) + xrow0 * 1024;
    f32x4 x[NR][4];
    if (a.xin16) {
#pragma unroll
        for (int r = 0; r < NR; ++r)
#pragma unroll
            for (int j = 0; j < 4; ++j) { const u32x2 xb = __builtin_nontemporal_load((const u32x2*)((const bf16_t*)(xi0 + (size_t)r * 1024) + 4 * lane + 256 * j));
                x[r][j] = (f32x4){bflo(xb.x), bfhi(xb.x), bflo(xb.y), bfhi(xb.y)}; }
    } else {
#pragma unroll
        for (int r = 0; r < NR; ++r)
#pragma unroll
            for (int j = 0; j < 4; ++j) x[r][j] = __builtin_nontemporal_load((const f32x4*)(xi0 + (size_t)r * 1024 + 4 * lane + 256 * j));
    }
#pragma unroll
    for (int br = 0; br < 2; ++br) {
        if (br == 0 ? !a.upd : !a.upd2) continue;
        const bf16_t* Yp = (br == 0 ? a.Y : a.Y2) + (size_t)row0 * 1024 + 4 * lane; const float* Pp = (br == 0 ? a.PART : a.PART2) + (size_t)row0 * 16 + (lane & 15);
        const float* gatep = (br == 0 ? a.gate : a.gate2) + (size_t)bb * 6144 + 4 * lane; const float* gpostp = (br == 0 ? a.gpost : a.gpost2) + 4 * lane;
        u32x2 yb[NR][4]; float ps[NR];
#pragma unroll
        for (int r = 0; r < NR; ++r) {
#pragma unroll
            for (int j = 0; j < 4; ++j) yb[r][j] = __builtin_nontemporal_load((const u32x2*)(Yp + (size_t)r * 1024 + 256 * j));
            ps[r] = Pp[r * 16];
        }
        float rstd[NR];
#pragma unroll
        for (int r = 0; r < NR; ++r) {
            float ss = ps[r]; ss += __shfl_xor(ss, 1); ss += __shfl_xor(ss, 2); ss += __shfl_xor(ss, 4); ss += __shfl_xor(ss, 8);
            rstd[r] = rsqrtf(ss * (1.0f / 1024.0f) + EPS);
        }
#pragma unroll
        for (int j = 0; j < 4; ++j) {
            const f32x4 gsc = *(const f32x4*)(gpostp + 256 * j) * *(const f32x4*)(gatep + 256 * j);
#pragma unroll
            for (int r = 0; r < NR; ++r) {
                const f32x4 y = {bflo(yb[r][j].x), bfhi(yb[r][j].x), bflo(yb[r][j].y), bfhi(yb[r][j].y)};
                x[r][j] = x[r][j] + gsc * (y * rstd[r]);
            }
        }
    }
    if (a.wr) {
        float* xo0 = (lat ? a.xoutL : a.xoutC) + xrow0 * 1024;
        if (a.xout16) {
#pragma unroll
            for (int r = 0; r < NR; ++r)
#pragma unroll
                for (int j = 0; j < 4; ++j) { u32x2 w; w.x = cvtpk(x[r][j][0], x[r][j][1]); w.y = cvtpk(x[r][j][2], x[r][j][3]);
                    __builtin_nontemporal_store(w, (u32x2*)((bf16_t*)(xo0 + (size_t)r * 1024) + 4 * lane + 256 * j)); }
        } else {
#pragma unroll
            for (int r = 0; r < NR; ++r)
#pragma unroll
                for (int j = 0; j < 4; ++j) __builtin_nontemporal_store(x[r][j], (f32x4*)(xo0 + (size_t)r * 1024 + 4 * lane + 256 * j));
        }
    }
    if (a.nxt) {
        float rstd2[NR];
#pragma unroll
        for (int r = 0; r < NR; ++r) {
            float s2 = 0.f;
#pragma unroll
            for (int j = 0; j < 4; ++j) s2 += (x[r][j][0] * x[r][j][0] + x[r][j][1] * x[r][j][1]) + (x[r][j][2] * x[r][j][2] + x[r][j][3] * x[r][j][3]);
            s2 = wave_sum(s2);
            rstd2[r] = rsqrtf(s2 * (1.0f / 1024.0f) + EPS);
        }
        const float* shp = a.sh + (size_t)bb * 6144 + 4 * lane; const float* scp = a.sc + (size_t)bb * 6144 + 4 * lane; const float* gp = a.gpre + 4 * lane;
        bf16_t* hp = a.H + (size_t)row0 * 1024 + 4 * lane;
#pragma unroll
        for (int j = 0; j < 4; ++j) {
            const f32x4 gm = *(const f32x4*)(gp + 256 * j) * (*(const f32x4*)(scp + 256 * j) + 1.0f), sv = *(const f32x4*)(shp + 256 * j);
#pragma unroll
            for (int r = 0; r < NR; ++r) {
                const f32x4 h = (x[r][j] * rstd2[r]) * gm + sv;
                u32x2 w; w.x = cvtpk(h[0], h[1]); w.y = cvtpk(h[2], h[3]);
                *(u32x2*)(hp + (size_t)r * 1024 + 256 * j) = w;
            }
        }
    }
}
DI void row_phase(const RowArgs& a, int gw, int ngw, int g) {
    int lane = threadIdx.x & 63; asm volatile("" : "+v"(lane));
    for (int rl = gw * 4; rl < a.M; rl += ngw * 4) {
        const int row = g * GROWS + rl;
        row_work<4>(a, row, lane);
    }
}

constexpr int AT_KB = 64 * 144, AT_VB = 64 * 144;
#define MFMA32(a, b, c) __builtin_amdgcn_mfma_f32_32x32x16_bf16((a), (b), (c), 0, 0, 0)
DI float fadd_s(float a, float b) { float r; asm("v_add_f32_e32 %0, %1, %2" : "=v"(r) : "v"(a), "v"(b)); return r; }
DI float swap_max(float m) { auto rr = __builtin_amdgcn_permlane32_swap(__float_as_uint(m), __float_as_uint(m), false, false); return fmaxf(__uint_as_float(rr[0]), __uint_as_float(rr[1])); }
DI float swap_sum(float m) { auto rr = __builtin_amdgcn_permlane32_swap(__float_as_uint(m), __float_as_uint(m), false, false); return __uint_as_float(rr[0]) + __uint_as_float(rr[1]); }
template <bool WINDOW, bool SINK, bool FIXED = false>
DI void attn_unit(LAS unsigned char* lds, const bf16_t* Qp, int qw, const bf16_t* Kb, int kvw, const bf16_t* Vb, bf16_t* Op,
                  int a_lo, int na, int qpos0, float sink2, float ref = 0.f) {
    int tid_ = threadIdx.x; asm volatile("" : "+v"(tid_));
    const int tid = tid_, lane = tid & 63, r32 = lane & 31, hi = lane >> 5; const int wid = __builtin_amdgcn_readfirstlane(tid >> 6);
    bf16x8 qf[4];
    { const bf16_t* qr = Qp + (size_t)(wid * 32 + r32) * qw + 8 * hi;
#pragma unroll
      for (int s = 0; s < 4; ++s) qf[s] = *(const bf16x8*)(qr + 16 * s); }
    constexpr float THR = 8.0f;
    float mhat = FIXED ? 0.f : (SINK ? sink2 : 0.f);
    float lrun = (SINK && hi == 0) ? (FIXED ? __builtin_amdgcn_exp2f(sink2) : 1.f) : 0.f;
    f32x16 o0, o1, negm;
    const f32x16 zero16 = {0.f, 0.f, 0.f, 0.f, 0.f, 0.f, 0.f, 0.f, 0.f, 0.f, 0.f, 0.f, 0.f, 0.f, 0.f, 0.f};
#pragma unroll
    for (int i = 0; i < 16; ++i) { o0[i] = 0.f; o1[i] = 0.f; negm[i] = -mhat; }
    const int srow = tid >> 3, sch = tid & 7;
    const int ntiles = na + 4;
    const int qw0 = qpos0 + wid * 32;
    const int qpos = qw0 + r32;
#define AT_KEY(tt) ((((tt) < na) ? (a_lo + (tt)) : (32 + (tt) - na)) * 64)
#define AT_SKIP(tt) (WINDOW && (tt) < na && (((a_lo + (tt)) * 64 + 63 < qw0 - 128) || ((a_lo + (tt)) * 64 > qw0 + 159)))
#define AT_LDK(key0) (*(const u32x4*)(Kb + (size_t)((key0) + srow) * kvw + sch * 8))
#define AT_LDV(key0) (*(const u32x4*)(Vb + (size_t)srow * KVR + (key0) + sch * 8))
#define AT_STK(buf, reg) (*(LAS u32x4*)(lds + (buf) * AT_KB + srow * 144 + sch * 16) = (reg))
#define AT_STV(buf, reg) (*(LAS u32x4*)(lds + 2 * AT_KB + (buf) * AT_VB + srow * 144 + sch * 16) = (reg))
#define AT_KRD(KL) do { _Pragma("unroll") for (int s_ = 0; s_ < 4; ++s_) { kf[2 * s_] = *(const LAS bf16x8*)((KL) + r32 * 144 + (16 * s_ + 8 * hi) * 2); \
        kf[2 * s_ + 1] = *(const LAS bf16x8*)((KL) + (32 + r32) * 144 + (16 * s_ + 8 * hi) * 2); } if (!FIXED) __builtin_amdgcn_sched_barrier(0); } while (0)
#define AT_QK(S0, S1, KL, s) do { \
        if ((s) == 0) { if (FIXED) { S0 = MFMA32(kf[0], qf[0], zero16); S1 = MFMA32(kf[1], qf[0], zero16); } else { S0 = MFMA32(kf[0], qf[0], negm); S1 = MFMA32(kf[1], qf[0], negm); } } else { S0 = MFMA32(kf[2 * (s)], qf[s], S0); S1 = MFMA32(kf[2 * (s) + 1], qf[s], S1); } } while (0)
#define AT_SUM(P, sq) do { lacc = fadd_s(fadd_s(fadd_s(fadd_s(lacc, P[8 * (sq) + 0]), P[8 * (sq) + 2]), P[8 * (sq) + 4]), P[8 * (sq) + 6]); lacc2 = fadd_s(fadd_s(fadd_s(fadd_s(lacc2, P[8 * (sq) + 1]), P[8 * (sq) + 3]), P[8 * (sq) + 5]), P[8 * (sq) + 7]); } while (0)
#define AT_VRD(VL) do { _Pragma("unroll") for (int ks_ = 0; ks_ < 4; ++ks_) { const int koff_ = (32 * (ks_ >> 1) + 16 * (ks_ & 1) + 8 * hi) * 2; \
        vf[2 * ks_] = *(const LAS bf16x8*)((VL) + r32 * 144 + koff_); vf[2 * ks_ + 1] = *(const LAS bf16x8*)((VL) + (32 + r32) * 144 + koff_); } if (!FIXED) __builtin_amdgcn_sched_barrier(0); } while (0)
#define AT_PV(VL, ks, P, sq) do { \
        u32x4 w_; w_.x = cvtpk(P[8 * (sq) + 0], P[8 * (sq) + 1]); w_.y = cvtpk(P[8 * (sq) + 2], P[8 * (sq) + 3]); w_.z = cvtpk(P[8 * (sq) + 4], P[8 * (sq) + 5]); w_.w = cvtpk(P[8 * (sq) + 6], P[8 * (sq) + 7]); \
        const bf16x8 pb_ = __builtin_bit_cast(bf16x8, w_); \
        o0 = MFMA32(vf[2 * (ks)], pb_, o0); o1 = MFMA32(vf[2 * (ks) + 1], pb_, o1); } while (0)
#define AT_EXP8(D, Sx, sq) do { _Pragma("unroll") for (int e_ = 0; e_ < 8; ++e_) D[8 * (sq) + e_] = __builtin_amdgcn_exp2f(Sx[8 * (sq) + e_]); } while (0)
#define AT_MASK(S0, S1, tt) do { \
        if (WINDOW && (tt) < na) { const int k0_ = (a_lo + (tt)) * 64; \
            if (!((k0_ >= qw0 + 31 - 128) && (k0_ + 63 <= qw0 + 128))) { const int x_ = qpos - k0_ - 4 * hi + 128; \
            _Pragma("unroll") for (int i = 0; i < 16; ++i) { const int c_ = (i & 3) + 8 * (i >> 2); \
                if ((unsigned)(x_ - c_) > 256u) S0[i] = -INFINITY; if ((unsigned)(x_ - c_ - 32) > 256u) S1[i] = -INFINITY; } } } } while (0)
#define AT_DECIDE(S0, S1, tt, FORCE) do { \
        if (WINDOW && (tt) < na) { const int k0_ = (a_lo + (tt)) * 64; \
            if (!((k0_ >= qw0 + 31 - 128) && (k0_ + 63 <= qw0 + 128))) { const int x_ = qpos - k0_ - 4 * hi + 128; \
            _Pragma("unroll") for (int i = 0; i < 16; ++i) { const int c_ = (i & 3) + 8 * (i >> 2); \
                if ((unsigned)(x_ - c_) > 256u) S0[i] = -INFINITY; if ((unsigned)(x_ - c_ - 32) > 256u) S1[i] = -INFINITY; } } } \
        float rm_ = fmaxf(S0[0], S1[0]); \
        _Pragma("unroll") for (int i = 1; i < 16; ++i) rm_ = fmaxf(fmaxf(rm_, S0[i]), S1[i]); \
        rm_ = swap_max(rm_); \
        const bool trig_ = (FORCE) || (rm_ > THR); \
        if (__builtin_amdgcn_ballot_w64(trig_) != 0ull) { \
            const float dl_ = (FORCE) ? rm_ : fmaxf(rm_, 0.f); mhat += dl_; \
            _Pragma("unroll") for (int i = 0; i < 16; ++i) { S0[i] -= dl_; S1[i] -= dl_; } \
            _Pragma("unroll") for (int i = 0; i < 16; ++i) negm[i] = -mhat; \
            fsave = __builtin_amdgcn_exp2f(-dl_); lrun *= fsave; resc = true; } } while (0)

    u32x4 kreg, vreg;
    kreg = AT_LDK(AT_KEY(0));
    AT_STK(0, kreg);
    kreg = AT_LDK(AT_KEY(1)); vreg = AT_LDV(AT_KEY(0));
    __syncthreads();
    f32x16 sn0, sn1, pc0, pc1;
    bf16x8 kf[8], vf[8];
    float fsave = 1.f; bool resc = false;
    bool have_cur = !AT_SKIP(0);
    if (have_cur) {
        const LAS unsigned char* Kl = lds;
        AT_KRD(Kl);
        AT_QK(sn0, sn1, Kl, 0); AT_QK(sn0, sn1, Kl, 1); AT_QK(sn0, sn1, Kl, 2); AT_QK(sn0, sn1, Kl, 3);
        if (!FIXED) { AT_DECIDE(sn0, sn1, 0, !SINK); } else { AT_MASK(sn0, sn1, 0); }
        AT_EXP8(pc0, sn0, 0); AT_EXP8(pc0, sn0, 1); AT_EXP8(pc1, sn1, 0); AT_EXP8(pc1, sn1, 1);
        if (resc) {
#pragma unroll
            for (int i = 0; i < 16; ++i) { o0[i] *= fsave; o1[i] *= fsave; }
            resc = false; }
    }
    AT_STK(1, kreg); AT_STV(0, vreg);
    __syncthreads();
#define AT_ITER(t, DD, KLD, VLD, KST, VST, MODE) do { \
        if (t + 2 + DD < ntiles) KLD = AT_LDK(AT_KEY(t + 2 + DD)); \
        if (t + 1 + DD < ntiles) VLD = AT_LDV(AT_KEY(t + 1 + DD)); \
        const bool have_next = ((MODE) == 1) ? true : ((MODE) == 2) ? false : ((t + 1 < ntiles) && !AT_SKIP(t + 1)); \
        const bool hc_ = ((MODE) != 0) ? true : have_cur; \
        const LAS unsigned char* Kl = lds + ((t + 1) & 1) * AT_KB; \
        const LAS unsigned char* Vl = lds + 2 * AT_KB + (t & 1) * AT_VB; \
        float lacc = 0.f, lacc2 = 0.f; \
        if (hc_ && have_next) { \
            AT_KRD(Kl); \
            AT_QK(sn0, sn1, Kl, 0); AT_SUM(pc0, 0); \
            AT_QK(sn0, sn1, Kl, 1); AT_SUM(pc0, 1); \
            AT_QK(sn0, sn1, Kl, 2); AT_SUM(pc1, 0); \
            AT_QK(sn0, sn1, Kl, 3); AT_SUM(pc1, 1); \
            lrun += lacc + lacc2; \
            if (!FIXED) __builtin_amdgcn_sched_barrier(0); \
            AT_VRD(Vl); \
            if (!FIXED) { AT_DECIDE(sn0, sn1, t + 1, false); } else { AT_MASK(sn0, sn1, t + 1); } \
            AT_PV(Vl, 0, pc0, 0); AT_EXP8(pc0, sn0, 0); \
            AT_PV(Vl, 1, pc0, 1); AT_EXP8(pc0, sn0, 1); \
            AT_PV(Vl, 2, pc1, 0); AT_EXP8(pc1, sn1, 0); \
            AT_PV(Vl, 3, pc1, 1); AT_EXP8(pc1, sn1, 1); \
        } else { \
            if (hc_) { AT_SUM(pc0, 0); AT_SUM(pc0, 1); AT_SUM(pc1, 0); AT_SUM(pc1, 1); lrun += lacc + lacc2; } \
            if (have_next) { AT_KRD(Kl); AT_QK(sn0, sn1, Kl, 0); AT_QK(sn0, sn1, Kl, 1); AT_QK(sn0, sn1, Kl, 2); AT_QK(sn0, sn1, Kl, 3); if (!FIXED) { AT_DECIDE(sn0, sn1, t + 1, false); } else { AT_MASK(sn0, sn1, t + 1); } } \
            if (hc_) { AT_VRD(Vl); AT_PV(Vl, 0, pc0, 0); AT_PV(Vl, 1, pc0, 1); AT_PV(Vl, 2, pc1, 0); AT_PV(Vl, 3, pc1, 1); } \
            if (have_next) { AT_EXP8(pc0, sn0, 0); AT_EXP8(pc0, sn0, 1); AT_EXP8(pc1, sn1, 0); AT_EXP8(pc1, sn1, 1); } \
        } \
        if (resc) { \
            _Pragma("unroll") \
            for (int i = 0; i < 16; ++i) { o0[i] *= fsave; o1[i] *= fsave; } \
            resc = false; } \
        if (t + 2 < ntiles) AT_STK(t & 1, KST); \
        if (t + 1 < ntiles) AT_STV((t + 1) & 1, VST); \
        __syncthreads(); \
        have_cur = have_next; \
    } while (0)
    if constexpr (!WINDOW) {
        u32x4 kreg2, vreg2;
        if (ntiles > 2) kreg2 = AT_LDK(AT_KEY(2));
        vreg2 = AT_LDV(AT_KEY(1));
        for (int t2 = 0; t2 < ntiles - 2; t2 += 2) {
            { const int t = t2; AT_ITER(t, 1, kreg, vreg, kreg2, vreg2, 1); }
            { const int t = t2 + 1; AT_ITER(t, 1, kreg2, vreg2, kreg, vreg, 1); }
        }
        { const int t = ntiles - 2; AT_ITER(t, 1, kreg, vreg, kreg2, vreg2, 1); }
        { const int t = ntiles - 1; AT_ITER(t, 1, kreg2, vreg2, kreg, vreg, 2); }
    } else {
        for (int t = 0; t < ntiles; ++t) { AT_ITER(t, 0, kreg, vreg, kreg, vreg, 0); }
    }
#undef AT_ITER
#undef AT_KEY
#undef AT_SKIP
#undef AT_LDK
#undef AT_LDV
#undef AT_STK
#undef AT_STV
#undef AT_QK
#undef AT_KRD
#undef AT_VRD
#undef AT_SUM
#undef AT_PV
#undef AT_EXP8
#undef AT_DECIDE
#undef AT_MASK
    const float lt = swap_sum(lrun);
    const float inv = 1.0f / lt;
    bf16_t* orow = Op + (size_t)(wid * 32 + r32) * 1024 + 4 * hi;
#pragma unroll
    for (int g = 0; g < 4; ++g) {
        u32x2 w0, w1;
        w0.x = cvtpk(o0[4 * g + 0] * inv, o0[4 * g + 1] * inv); w0.y = cvtpk(o0[4 * g + 2] * inv, o0[4 * g + 3] * inv);
        w1.x = cvtpk(o1[4 * g + 0] * inv, o1[4 * g + 1] * inv); w1.y = cvtpk(o1[4 * g + 2] * inv, o1[4 * g + 3] * inv);
        *(u32x2*)(orow + 8 * g) = w0; *(u32x2*)(orow + 32 + 8 * g) = w1;
    }
}

template <int GI>
DI void pool_unit_t(int rt, const bf16_t* U, const bf16_t* WpT, const float* pscale, bf16_t* MIX) {
    constexpr int g = GI, w = 2 << GI, hw = w >> 1;
    int tid_ = threadIdx.x; asm volatile("" : "+v"(tid_));
    const int tid = tid_, lane = tid & 63, fr = lane & 15, fq = lane >> 4; const int wid = __builtin_amdgcn_readfirstlane(tid >> 6);
    const int row = rt * 128 + wid * 16 + fr;
    const int rlq = row % GROWS;
    const bool lat = rlq < GLAT;
    const int t = lat ? (rlq & (SEQ - 1)) : ((rlq - GLAT) & (CTX - 1));
    const int S = lat ? SEQ : CTX;
    const int base = row - t;
    const int lo = (t - hw) < 0 ? 0 : (t - hw), hi = (t + hw) > S ? S : (t + hw);
    const float icnt = 1.0f / (float)(hi - lo);
    bf16x8 af[4];
#pragma unroll
    for (int ks = 0; ks < 4; ++ks) {
        const int c0 = g * 128 + 32 * ks + 8 * fq;
        u32x4 uv[w];
#pragma unroll
        for (int j = 0; j < w; ++j) {
            const int p = t - hw + j; const bool ok = (p >= 0 && p < S);
            uv[j] = *(const u32x4*)(U + (size_t)(base + (ok ? p : t)) * 512 + c0);
        }
        const u32x4 us = *(const u32x4*)(U + (size_t)row * 512 + c0);
        float sum[8];
#pragma unroll
        for (int e = 0; e < 8; ++e) sum[e] = 0.f;
#pragma unroll
        for (int j = 0; j < w; ++j) {
            const int p = t - hw + j; const float wt = (p >= 0 && p < S) ? 1.0f : 0.0f;
            sum[0] += wt * bflo(uv[j].x); sum[1] += wt * bfhi(uv[j].x); sum[2] += wt * bflo(uv[j].y); sum[3] += wt * bfhi(uv[j].y);
            sum[4] += wt * bflo(uv[j].z); sum[5] += wt * bfhi(uv[j].z); sum[6] += wt * bflo(uv[j].w); sum[7] += wt * bfhi(uv[j].w);
        }
        const float u0 = bflo(us.x), u1 = bfhi(us.x), u2 = bflo(us.y), u3 = bfhi(us.y), u4 = bflo(us.z), u5 = bfhi(us.z), u6 = bflo(us.w), u7 = bfhi(us.w);
        u32x4 d; d.x = cvtpk(sum[0] * icnt - u0, sum[1] * icnt - u1); d.y = cvtpk(sum[2] * icnt - u2, sum[3] * icnt - u3);
        d.z = cvtpk(sum[4] * icnt - u4, sum[5] * icnt - u5); d.w = cvtpk(sum[6] * icnt - u6, sum[7] * icnt - u7);
        af[ks] = __builtin_bit_cast(bf16x8, d);
    }
    const bf16_t* wp = WpT + (size_t)g * 128 * 128;
#pragma unroll
    for (int nt = 0; nt < 8; ++nt) {
        f32x4 acc = {0.f, 0.f, 0.f, 0.f};
#pragma unroll
        for (int ks = 0; ks < 4; ++ks) {
            const bf16x8 bfrag = *(const bf16x8*)(wp + (size_t)(16 * nt + fr) * 128 + 32 * ks + 8 * fq);
            acc = __builtin_amdgcn_mfma_f32_16x16x32_bf16(bfrag, af[ks], acc, 0, 0, 0);
        }
        const int n = g * 128 + 16 * nt + 4 * fq;
        const f32x4 ps = *(const f32x4*)(pscale + n);
        u32x2 w2; w2.x = cvtpk(acc[0] * ps[0], acc[1] * ps[1]); w2.y = cvtpk(acc[2] * ps[2], acc[3] * ps[3]);
        *(u32x2*)(MIX + (size_t)row * 1024 + 512 + n) = w2;
    }
}
DI void pool_unit(int rt, int g, const bf16_t* U, const bf16_t* WpT, const float* pscale, bf16_t* MIX) {
    if (g == 0) pool_unit_t<0>(rt, U, WpT, pscale, MIX);
    else if (g == 1) pool_unit_t<1>(rt, U, WpT, pscale, MIX);
    else if (g == 2) pool_unit_t<2>(rt, U, WpT, pscale, MIX);
    else pool_unit_t<3>(rt, U, WpT, pscale, MIX);
}

#define XB_TMO      128
#define XB_XCNT(j)  (256  + 64 * (j))
#define XB_XSUB(j)  (1280 + 64 * (j))
#define XB_XGEN(j)  (2304 + 64 * (j))
#define XB_TOP      3328
#define XB_TOPGEN   3392
#define XCD_BAR_WORDS 3456
#define XB_SPIN_CAP (1u << 18)
__device__ __forceinline__ unsigned xb_ld(unsigned* p)              { return __hip_atomic_load(p, __ATOMIC_RELAXED, __HIP_MEMORY_SCOPE_AGENT); }
__device__ __forceinline__ unsigned xb_add(unsigned* p, unsigned v) { return __hip_atomic_fetch_add(p, v, __ATOMIC_RELAXED, __HIP_MEMORY_SCOPE_AGENT); }
__device__ __forceinline__ unsigned xb_xcc_id() { return (unsigned)__builtin_amdgcn_s_getreg((3 << 11) | 20) & 0xFu; }
#define XB_SPIN(cond, bar) do { unsigned _sp = 0; while (cond) { __builtin_amdgcn_s_sleep(1); \
    if ((++_sp & 255u) == 0u) { if (xb_ld(&(bar)[XB_TMO])) break; if (_sp > XB_SPIN_CAP) { atomicAdd(&(bar)[XB_TMO], 1u); break; } } } } while (0)
struct XcdBarrier { unsigned* bar; unsigned x; volatile LAS unsigned* st; unsigned gsize; };
__device__ __forceinline__ XcdBarrier xcd_barrier_post(unsigned* bar, volatile LAS unsigned* st, unsigned gsize) {
    XcdBarrier b; b.bar = bar; b.x = xb_xcc_id(); b.st = st; b.gsize = gsize;
    if (threadIdx.x == 0) (void)xb_add(&bar[XB_XCNT(b.x)], 1u);
    return b;
}
__device__ __forceinline__ void xcd_barrier_complete(unsigned* bar, unsigned x, unsigned G, unsigned& nloc, unsigned& nx) {
    unsigned sum, cnt, mine, sp = 0u;
    for (;;) {
        sum = 0u; cnt = 0u; mine = 0u;
#pragma unroll
        for (unsigned j = 0; j < 16; ++j) { const unsigned c = xb_ld(&bar[XB_XCNT(j)]); sum += c; cnt += (c > 0u) ? 1u : 0u; mine = (j == x) ? c : mine; }
        if (sum == G) break;
        __builtin_amdgcn_s_sleep(1);
        if ((++sp & 255u) == 0u) { if (xb_ld(&bar[XB_TMO])) break; if (sp > XB_SPIN_CAP) { atomicAdd(&bar[XB_TMO], 1u); break; } }
    }
    nloc = mine > 0u ? mine : 1u; nx = cnt > 0u ? cnt : 1u;
}
__device__ __forceinline__ void xcd_barrier(const XcdBarrier& b) {
    asm volatile("s_waitcnt vmcnt(0)" ::: "memory");
    __syncthreads();
    if (threadIdx.x == 0) {
        unsigned* bar = b.bar; asm volatile("" : "+s"(bar));
        unsigned bx_ = b.x; asm volatile("" : "+s"(bx_));
        __builtin_amdgcn_s_waitcnt(0);
        unsigned nloc = b.st[0], nx = b.st[1];
        if (nloc == 0u) { xcd_barrier_complete(bar, bx_, b.gsize, nloc, nx); b.st[0] = nloc; b.st[1] = nx; }
        const unsigned old = xb_add(&bar[XB_XSUB(bx_)], 1u);
        const unsigned gen = old / nloc;
        if (old + 1u == (gen + 1u) * nloc) {
            __builtin_amdgcn_fence(__ATOMIC_RELEASE, "agent");
            asm volatile("s_waitcnt vmcnt(0)" ::: "memory");
            const unsigned og = xb_add(&bar[XB_TOP], 1u);
            const unsigned tg = og / nx;
            if (og + 1u == (tg + 1u) * nx) xb_add(&bar[XB_TOPGEN], 1u);
            else XB_SPIN(xb_ld(&bar[XB_TOPGEN]) == tg, bar);
            __builtin_amdgcn_fence(__ATOMIC_ACQUIRE, "agent");
            xb_add(&bar[XB_XGEN(bx_)], 1u);
            asm volatile("s_waitcnt vmcnt(0)" ::: "memory");
        } else {
            XB_SPIN(xb_ld(&bar[XB_XGEN(bx_)]) == gen, bar);
            __builtin_amdgcn_fence(__ATOMIC_ACQUIRE, "agent");
            asm volatile("s_waitcnt vmcnt(0)" ::: "memory");
        }
    }
    __syncthreads();
}

struct Args { const float* in[21]; float* out; unsigned char* ws; int never; int pad; };
constexpr size_t CTL_FLAG = 31744;
constexpr int STAGGER_SPIN = 0;

__global__ void __launch_bounds__(512, 2) fwd_megakernel(Args args) {
    extern __shared__ __attribute__((aligned(16))) unsigned char lds_raw[];
    LAS unsigned char* lds = (LAS unsigned char*)lds_raw;
    cg::grid_group grid = cg::this_grid();
    const int tid = threadIdx.x; const int wave = __builtin_amdgcn_readfirstlane(tid >> 6);
    const int G = gridDim.x, bx = blockIdx.x;
    const int grp = (bx >> 3) & 1, c = ((bx >> 4) << 3) | (bx & 7), Gg = G >> 1;
    volatile LAS unsigned* xst = (volatile LAS unsigned*)(lds + LDS_BYTES - 16);
    if (tid < 4) xst[tid] = 0u;
    __syncthreads();
    XcdBarrier xbar = xcd_barrier_post((unsigned*)args.ws + grp * 4096, xst, (unsigned)Gg);
    XcdBarrier gbar = xcd_barrier_post((unsigned*)args.ws + 2 * 4096, xst + 2, (unsigned)G);
#define GBAR() xcd_barrier(xbar)
    unsigned char* ws = args.ws;
    unsigned* flagw = (unsigned*)(ws + CTL_FLAG);
    const float* x_in = args.in[0]; const float* c_in = args.in[1]; const float* ctx_in = args.in[2]; const float* cctx_in = args.in[3];
    const float* w_mod = args.in[4]; const float* b_mod = args.in[5];
    const float* g_pre_mix = args.in[6]; const float* g_post_mix = args.in[7]; const float* g_pre_ffn = args.in[8]; const float* g_post_ffn = args.in[9];
    const float* we_in = args.in[10]; const float* we_out = args.in[11]; const float* we_qg = args.in[12]; const float* we_kg = args.in[13];
    const float* we_pool = args.in[14]; const float* we_pscale = args.in[15];
    const float* wo_in = args.in[16]; const float* wo_out = args.in[17]; const float* wo_sink = args.in[18];
    const float* w_f1 = args.in[19]; const float* w_f2 = args.in[20];
    float* out = args.out;
    float* MOD = (float*)(ws + WS_MOD); float* PART = (float*)(ws + WS_PART); float* PART2 = (float*)(ws + WS_PART2); bf16_t* Y2 = (bf16_t*)(ws + WS_Y2);
    float* XC = (float*)(ws + WS_XC);
    bf16_t* H = (bf16_t*)(ws + WS_H); bf16_t* Y = (bf16_t*)(ws + WS_Y);
    unsigned char* arena = ws + WS_Q + (size_t)grp * (216 * MiB);
    bf16_t* Ub = (bf16_t*)(arena + 108 * MiB) - (size_t)grp * GROWS * 512; bf16_t* MIX = (bf16_t*)(arena + 144 * MiB) - (size_t)grp * GROWS * 1024;
    bf16_t* ACT = (bf16_t*)arena - (size_t)grp * GROWS * FFN;
    const int gw = c * 8 + wave, ngw = Gg * 8;
    const int xl = c & 7, jl = c >> 3;

    for (int it = bx; it < 4 * 48; it += G) mod_item(it, c_in, cctx_in, w_mod, b_mod, MOD, lds);
    for (int l = 0; l < NLAYER; ++l) prep_layer(l, bx, G, ws, lds, we_in, we_out, we_pool, wo_in, wo_out, w_f1, w_f2);
    if (args.never) grid.sync();
    xcd_barrier(gbar);
    {
        RowArgs a{}; a.xinL = x_in; a.xinC = ctx_in; a.H = H; a.gpre = g_pre_mix; a.sh = MOD; a.sc = MOD + 1024; a.M = 36864; a.upd = 0; a.upd2 = 0; a.wr = 0; a.nxt = 1;
        row_phase(a, gw, ngw, grp);
    }
    GBAR();
    for (int l = 0; l < NLAYER; ++l) {
        const int li = l >> 1; const bool ev = (l & 1) == 0; const bool with_ctx = l < NLAYER - 1;
        const int Mlog = with_ctx ? 36864 : 32768;
        unsigned char* wl = ws + WS_W + (size_t)l * WL_STRIDE;
        float* MODl = MOD + (size_t)l * 33 * 6144;
        bf16_t* Qb = (bf16_t*)arena - (size_t)grp * GROWS * (ev ? 512 : 1024);
        bf16_t* Kb = (bf16_t*)(arena + 72 * MiB) - (size_t)(16 * grp) * KVR * (ev ? 128 : 256);
        bf16_t* Vt = (bf16_t*)(arena + 90 * MiB) - (size_t)(16 * grp) * (ev ? 2 : 4) * 64 * KVR;
        {
            pg8::Gemm g{H, (const bf16_t*)(wl + WL_IN), 36864, ev ? 1280 : 1536, 1024}; pg8::GroupOrder S; S.init(g.M, g.N, Gg, c, grp);
            LAS float* ropel = (LAS float*)(lds + 131072);
            rope_table(ropel); __syncthreads();
            EpiQKV E{ev ? 1 : 0, Qb, Kb, Vt, Ub, we_qg + li * 64, we_kg + li * 64, ropel, ev ? (unsigned*)nullptr : (unsigned*)(ws + 49152) + li * 640};
            pg8::gemm_phase<EpiQKV, pg8::GroupOrder>(lds, g, S, E);
        }
        GBAR();
        if (ev) {
            const int n_dense = 1024, n_ctx = with_ctx ? 128 : 0;
            float bref;
            { const int ln = tid & 63; float gq = fabsf(we_qg[li * 64 + ln]), gk = fabsf(we_kg[li * 64 + ln]);
#pragma unroll
              for (int o = 1; o < 64; o <<= 1) { gq = fmaxf(gq, __shfl_xor(gq, o)); gk = fmaxf(gk, __shfl_xor(gk, o)); }
              bref = __uint_as_float(__builtin_amdgcn_readfirstlane(__float_as_uint(64.0f * C2 * gq * gk * 1.02f + 0.25f))); }
            for (int u = c; u < n_dense + n_ctx; u += Gg) {
                int b, head, qrow0, na;
                if (u < n_dense) { int qb = u & 7; head = (u >> 3) & 7; int bl = u >> 6;
                    if (Gg == 128) { const int i = u >> 7, pr = (i >> 1) * 8 + xl, idx = (i & 1) * 16 + jl; bl = pr >> 1; head = (pr & 1) * 4 + (idx >> 3); qb = idx & 7; }
                    b = 16 * grp + bl; qrow0 = grp * GROWS + bl * SEQ + qb * 256; na = 32; }
                else { const int v = u - n_dense; head = v & 7; b = 16 * grp + (v >> 3); qrow0 = grp * GROWS + GLAT + (v >> 3) * CTX; na = 0; }
                const int kvh = head >> 2;
                if (bref <= 40.0f) attn_unit<false, false, true>(lds, Qb + (size_t)qrow0 * 512 + head * 64, 512, Kb + (size_t)b * KVR * 128 + kvh * 64, 128, Vt + (size_t)(b * 2 + kvh) * 64 * KVR,
                                                              MIX + (size_t)qrow0 * 1024 + head * 64, 0, na, 0, 0.f, bref);
                else attn_unit<false, false, false>(lds, Qb + (size_t)qrow0 * 512 + head * 64, 512, Kb + (size_t)b * KVR * 128 + kvh * 64, 128, Vt + (size_t)(b * 2 + kvh) * 64 * KVR,
                                                    MIX + (size_t)qrow0 * 1024 + head * 64, 0, na, 0, 0.f);
            }
            const int n_rt = Mlog / 128, n_pool = n_rt * 4;
            for (int u = c; u < n_pool; u += Gg) { const int tl = u % n_rt; const int rt = grp * (GROWS / 128) + tl;
                pool_unit(rt, u / n_rt, Ub, (const bf16_t*)(wl + WL_POOL), we_pscale + li * 512, MIX); }
        } else {
            const int n_win = 2048, n_ctx = with_ctx ? 256 : 0;
            for (int u = c; u < n_win + n_ctx; u += Gg) {
                if (u < n_win) {
                    int qb = u & 7, head = (u >> 3) & 15, bl = u >> 7;
                    if (Gg == 128) { const int i = u >> 7, pr = (i >> 1) * 8 + xl, idx = (i & 1) * 16 + jl; bl = pr >> 2; head = (pr & 3) * 4 + (idx >> 3); qb = ((idx & 7) + (i >> 1)) & 7; }
                    const int b = 16 * grp + bl; const int q0 = qb * 256, qrow0 = grp * GROWS + bl * SEQ + q0, kvh = head >> 2;
                    const int klo = (q0 - 128) < 0 ? 0 : (q0 - 128), khi = (q0 + 384) > SEQ ? SEQ : (q0 + 384);
                    const float sk = wo_sink[li * 16 + head] * LOG2E;
                    unsigned* mwp = (unsigned*)(ws + 49152) + li * 640 + b * 20;
                    const float mq2 = __uint_as_float(__builtin_amdgcn_readfirstlane(__hip_atomic_load(mwp + head, __ATOMIC_RELAXED, __HIP_MEMORY_SCOPE_AGENT)));
                    const float mk2 = __uint_as_float(__builtin_amdgcn_readfirstlane(__hip_atomic_load(mwp + 16 + kvh, __ATOMIC_RELAXED, __HIP_MEMORY_SCOPE_AGENT)));
                    const float refw = fmaxf(sqrtf(mq2 * mk2) * 1.02f + 0.25f, sk);
                    if (refw <= 50.0f && sk >= -60.0f)
                        attn_unit<true, true, true>(lds, Qb + (size_t)qrow0 * 1024 + head * 64, 1024, Kb + (size_t)b * KVR * 256 + kvh * 64, 256, Vt + (size_t)(b * 4 + kvh) * 64 * KVR,
                                                    MIX + (size_t)qrow0 * 1024 + head * 64, klo >> 6, (khi - klo) >> 6, q0, sk, refw);
                    else
                    attn_unit<true, true>(lds, Qb + (size_t)qrow0 * 1024 + head * 64, 1024, Kb + (size_t)b * KVR * 256 + kvh * 64, 256, Vt + (size_t)(b * 4 + kvh) * 64 * KVR,
                                          MIX + (size_t)qrow0 * 1024 + head * 64, klo >> 6, (khi - klo) >> 6, q0, sk);
                } else {
                    const int v = u - n_win, head = v & 15, b = 16 * grp + (v >> 4); const int qrow0 = grp * GROWS + GLAT + (v >> 4) * CTX, kvh = head >> 2;
                    const float sk = wo_sink[li * 16 + head] * LOG2E;
                    attn_unit<false, true>(lds, Qb + (size_t)qrow0 * 1024 + head * 64, 1024, Kb + (size_t)b * KVR * 256 + kvh * 64, 256, Vt + (size_t)(b * 4 + kvh) * 64 * KVR,
                                           MIX + (size_t)qrow0 * 1024 + head * 64, 0, 0, 0, sk);
                }
            }
        }
        GBAR();
        {
            pg8::Gemm g{MIX, (const bf16_t*)(wl + WL_OUT), Mlog, 1024, 1024}; pg8::GroupOrder S; S.init(g.M, g.N, Gg, c, grp);
            EpiY E{Y, PART};
            pg8::gemm_phase<EpiY, pg8::GroupOrder>(lds, g, S, E);
        }
        GBAR();
        {
            RowArgs a{}; a.xinL = (l == 0) ? x_in : out; a.xinC = (l == 0) ? ctx_in : XC; a.xoutL = out; a.xoutC = XC;
            a.Y = Y; a.PART = PART; a.gate = MODl + 2048; a.gpost = g_post_mix + l * 1024;
            a.H = H; a.gpre = g_pre_ffn + l * 1024; a.sh = MODl + 3072; a.sc = MODl + 4096; a.M = Mlog; a.upd = 1; a.upd2 = 0; a.wr = 0; a.nxt = 1; a.xin16 = (l > 0) ? 1 : 0;
            row_phase(a, gw, ngw, grp);
        }
        GBAR();
        {
            pg8::Gemm g{H, (const bf16_t*)(wl + WL_F1), Mlog, 2 * FFN, 1024}; pg8::GroupOrder S; S.init(g.M, g.N, Gg, c, grp);
            EpiSwiGLU E{ACT};
            pg8::gemm_phase<EpiSwiGLU, pg8::GroupOrder>(lds, g, S, E);
        }
        GBAR();
        {
            pg8::Gemm g{ACT, (const bf16_t*)(wl + WL_F2), Mlog, 1024, FFN}; pg8::GroupOrder S; S.init(g.M, g.N, Gg, c, grp);
            EpiY E{Y2, PART2};
            pg8::gemm_phase<EpiY, pg8::GroupOrder>(lds, g, S, E);
        }
        GBAR();
        {
            RowArgs a{}; a.xinL = (l == 0) ? x_in : out; a.xinC = (l == 0) ? ctx_in : XC; a.xoutL = out; a.xoutC = XC;
            a.Y = Y; a.PART = PART; a.gate = MODl + 2048; a.gpost = g_post_mix + l * 1024;
            a.Y2 = Y2; a.PART2 = PART2; a.gate2 = MODl + 5120; a.gpost2 = g_post_ffn + l * 1024;
            a.H = H; a.gpre = g_pre_mix + (l + 1 < NLAYER ? l + 1 : l) * 1024; a.sh = MODl + 33 * 6144; a.sc = MODl + 33 * 6144 + 1024; a.M = Mlog; a.upd = 1; a.upd2 = 1; a.wr = 1; a.nxt = with_ctx ? 1 : 0; a.xin16 = (l > 0) ? 1 : 0; a.xout16 = with_ctx ? 1 : 0;
            row_phase(a, gw, ngw, grp);
        }
        if (l + 1 < NLAYER) GBAR();
    }
#undef GBAR
}

extern "C" void kernel_launch(void* const* d_in, const int* in_sizes, int n_in, void* d_out, int out_size, void* d_ws, size_t ws_size, hipStream_t stream) {
    static int grid = 0;
    if (grid == 0) {
        if (n_in != 21 || out_size != NL * DM || ws_size < WS_END) { fprintf(stderr, "kernel_launch: unexpected shapes (n_in %d out %d ws %zu)\n", n_in, out_size, ws_size); grid = -1; return; }
        int dev = 0, cus = 0, per_cu = 0;
        (void)hipGetDevice(&dev);
        (void)hipDeviceGetAttribute(&cus, hipDeviceAttributeMultiprocessorCount, dev);
        if (hipFuncSetAttribute((const void*)fwd_megakernel, hipFuncAttributeMaxDynamicSharedMemorySize, LDS_BYTES) != hipSuccess) { fprintf(stderr, "kernel_launch: hipFuncSetAttribute failed\n"); }
        if (hipOccupancyMaxActiveBlocksPerMultiprocessor(&per_cu, (const void*)fwd_megakernel, 512, LDS_BYTES) != hipSuccess || per_cu < 1) { fprintf(stderr, "kernel_launch: occupancy query says %d\n", per_cu); per_cu = 1; }
        (void)hipGetLastError();
        if (per_cu > 1) per_cu = 1;
        grid = (cus * per_cu) & ~1;
    }
    if (grid < 0) return;
    if (hipMemsetAsync(d_ws, 0, 57344, stream) != hipSuccess) { fprintf(stderr, "kernel_launch: memset of barrier words failed\n"); return; }
    Args a{};
    for (int i = 0; i < 21; ++i) a.in[i] = (const float*)d_in[i];
    a.out = (float*)d_out; a.ws = (unsigned char*)d_ws;
    void* kargs[] = {&a};
    hipError_t e = hipLaunchCooperativeKernel((const void*)fwd_megakernel, dim3(grid), dim3(512), kargs, LDS_BYTES, stream);
    if (e != hipSuccess) fprintf(stderr, "cooperative launch failed: %s (grid %d)\n", hipGetErrorString(e), grid);
}
```
